# Optimizing an MI355X kernel written in HIP

```python
import math
import numpy as np
import jax
import jax.numpy as jnp
from jax import lax

D_MODEL = 1024
BATCH = 4
SEQ = 4096
DEPTH = 2
DEC_BATCH = 32
DEC_SEQ = 8
PAST_LEN = 8192
PAGE_SIZE = 128

N_MIXERS = 2
N_HGRN_LAYERS = (DEPTH + N_MIXERS - 1) // N_MIXERS
N_ATTN_LAYERS = DEPTH // N_MIXERS
HG_EXPAND = 128
HG_HEADS = D_MODEL // HG_EXPAND
HG_DK = HG_EXPAND
HG_DV = D_MODEL // HG_HEADS
HG_WIDTH = HG_HEADS * HG_DK
HG_CHUNK = 64
GROUPS = ((128, 1), (512, 4), (2048, 16))
N_GROUPS = len(GROUPS)
ATT_HEAD_DIM = 64
ATT_HEADS = D_MODEL // ATT_HEAD_DIM
ATT_WIDTH = ATT_HEADS * ATT_HEAD_DIM
ATT_SCALE = ATT_HEAD_DIM ** -0.5
D_FF = 4 * D_MODEL
RMS_EPS = 1e-6

kernel_name = 'hybrid_hgrn2_dilated_swa_step'


def _rmsnorm(x, w):
    x32 = x.astype(jnp.float32)
    y = x32 * lax.rsqrt(jnp.mean(x32 * x32, axis=-1, keepdims=True) + RMS_EPS) * w.astype(jnp.float32)
    return y.astype(x.dtype)


def _alibi_slopes():
    n = N_GROUPS * ATT_HEADS
    s = 2.0 ** (-8.0 * np.arange(1, n + 1) / n)
    return jnp.asarray(s.reshape(N_GROUPS, ATT_HEADS), dtype=jnp.float32)


def _sqrelu_mlp(x, w_up, w_down):
    h = jax.nn.relu(x @ w_up)
    return (h * h) @ w_down


def _hgrn_recurrence(q, k, v, logf, s0):
    b_, t_, h_, _ = q.shape
    dv = v.shape[-1]
    c = math.gcd(t_, HG_CHUNK)
    n = t_ // c

    def chunks(a):
        return a.astype(jnp.float32).reshape(b_, n, c, h_, a.shape[-1]).transpose(1, 0, 3, 2, 4)

    causal = jnp.tril(jnp.ones((c, c), dtype=bool))

    def step(s, inp):
        qc, kc, vc, gc = inp
        cum = jnp.cumsum(gc, axis=2)
        diff = cum[:, :, :, None, :] - cum[:, :, None, :, :]
        decay = jnp.exp(jnp.where(causal[:, :, None], diff, -jnp.inf))
        attn = jnp.einsum('bhtk,bhsk,bhtsk->bhts', qc, kc, decay)
        o = jnp.einsum('bhts,bhsv->bhtv', attn, vc) + jnp.einsum('bhtk,bhkv->bhtv', qc * jnp.exp(cum), s)
        last = cum[:, :, -1:, :]
        s_new = jnp.exp(last[:, :, 0, :, None]) * s + jnp.einsum('bhsk,bhsv->bhkv', kc * jnp.exp(last - cum), vc)
        return s_new, o

    s_t, o = lax.scan(step, s0.astype(jnp.float32), (chunks(q), chunks(k), chunks(v), chunks(logf)))
    o = o.transpose(1, 0, 3, 2, 4).reshape(b_, t_, h_, dv)
    return o, s_t


def _hgrn_mixer(xn, s0, lb, w_q, w_f, w_i, w_g, w_o, w_gnorm):
    b_, t_, _ = xn.shape

    def heads(a):
        return a.reshape(b_, t_, HG_HEADS, -1)

    q = jax.nn.silu(xn @ w_q)
    f = lb + (1.0 - lb) * jax.nn.sigmoid((xn @ w_f).astype(jnp.float32))
    k = 1.0 - f
    i = xn @ w_i
    o, s_t = _hgrn_recurrence(heads(q), heads(k), heads(i), heads(jnp.log(f)), s0)
    o = _rmsnorm(o.reshape(b_, t_, HG_WIDTH), w_gnorm) * jax.nn.silu((xn @ w_g).astype(jnp.float32))
    return o.astype(xn.dtype) @ w_o, s_t


def _qkv(xn, w_qkv, w_qn, w_kn):
    b_, t_, _ = xn.shape
    qkv = (xn @ w_qkv).reshape(b_, t_, 3, N_GROUPS, ATT_HEADS, ATT_HEAD_DIM)
    q = _rmsnorm(qkv[:, :, 0], w_qn)
    k = _rmsnorm(qkv[:, :, 1], w_kn)
    return q, k, qkv[:, :, 2]


def _banded_window(q, k, v, n_back, slopes):
    n_, l_, h_, dh = q.shape
    bq = n_back
    nb = -(-l_ // bq)
    pad = nb * bq - l_
    qb = jnp.pad(q, ((0, 0), (0, pad), (0, 0), (0, 0))).reshape(n_, nb, bq, h_, dh)

    def key_blocks(a):
        ap = jnp.pad(a, ((0, 0), (bq, pad), (0, 0), (0, 0)))
        prev = ap[:, :nb * bq].reshape(n_, nb, bq, h_, dh)
        cur = ap[:, bq:].reshape(n_, nb, bq, h_, dh)
        return jnp.concatenate([prev, cur], axis=2)

    kb, vb = key_blocks(k), key_blocks(v)
    dist = jnp.arange(bq)[:, None] - jnp.arange(2 * bq)[None, :] + bq
    band = (dist >= 0) & (dist <= n_back)
    before_start = (jnp.arange(nb)[:, None, None] == 0) & (jnp.arange(2 * bq)[None, None, :] < bq)
    valid = band[None] & ~before_start
    s = jnp.einsum('nbqhd,nbkhd->nbhqk', qb, kb, preferred_element_type=jnp.float32) * ATT_SCALE
    s = s - slopes[:, None, None] * dist.astype(jnp.float32)
    s = jnp.where(valid[:, None], s, -jnp.inf)
    lse = jax.nn.logsumexp(s, axis=-1)
    p = jnp.exp(s - lse[..., None])
    o = jnp.einsum('nbhqk,nbkhd->nbqhd', p, vb.astype(jnp.float32))
    o = o.reshape(n_, nb * bq, h_, dh)[:, :l_]
    lse = lse.transpose(0, 1, 3, 2).reshape(n_, nb * bq, h_)[:, :l_]
    return o, lse


def _dilated_prompt(q, k, v, window, dilation, slopes):
    b_, t_, h_, dh = q.shape
    l_ = t_ // dilation

    def to_sub(a):
        return a.reshape(b_, l_, dilation, h_, dh).transpose(0, 2, 1, 3, 4).reshape(b_ * dilation, l_, h_, dh)

    o, lse = _banded_window(to_sub(q), to_sub(k), to_sub(v), window // dilation, slopes * dilation)
    o = o.reshape(b_, dilation, l_, h_, dh).transpose(0, 2, 1, 3, 4).reshape(b_, t_, h_, dh)
    lse = lse.reshape(b_, dilation, l_, h_).transpose(0, 2, 1, 3).reshape(b_, t_, h_)
    return o, lse


def _dilated_sample(q, k_all, v_all, window, dilation, slopes):
    s_new = q.shape[1]
    first = k_all.shape[1] - s_new
    steps = jnp.arange(window // dilation + 1)
    idx = first + jnp.arange(s_new)[:, None] - dilation * steps[None, :]
    valid = idx >= 0
    idx = jnp.maximum(idx, 0)
    kg = k_all[:, idx]
    vg = v_all[:, idx]
    s = jnp.einsum('bshd,bskhd->bhsk', q, kg, preferred_element_type=jnp.float32) * ATT_SCALE
    s = s - slopes[None, :, None, None] * (dilation * steps).astype(jnp.float32)
    s = jnp.where(valid[None, None], s, -jnp.inf)
    lse = jax.nn.logsumexp(s, axis=-1)
    p = jnp.exp(s - lse[..., None])
    o = jnp.einsum('bhsk,bskhd->bshd', p, vg.astype(jnp.float32))
    return o, lse.transpose(0, 2, 1)


def _merge_groups(outs, lses):
    wts = jax.nn.softmax(jnp.stack(lses, axis=0), axis=0)
    o = jnp.einsum('gbth,gbthd->bthd', wts, jnp.stack(outs, axis=0))
    return o.reshape(o.shape[0], o.shape[1], ATT_WIDTH)


def _attn_prompt(xn, w_qkv, w_o, w_qn, w_kn):
    q, k, v = _qkv(xn, w_qkv, w_qn, w_kn)
    slopes = _alibi_slopes()
    t_ = xn.shape[1]
    outs, lses, rows = [], [], []
    for g, (window, dilation) in enumerate(GROUPS):
        o, lse = _dilated_prompt(q[:, :, g], k[:, :, g], v[:, :, g], window, dilation, slopes[g])
        outs.append(o)
        lses.append(lse)
        keep = min(window, t_)
        rows.append(jnp.stack([k[:, t_ - keep:, g], v[:, t_ - keep:, g]], axis=2))
    return _merge_groups(outs, lses).astype(xn.dtype) @ w_o, rows


def _attn_sample(xn, bufs, w_qkv, w_o, w_qn, w_kn):
    q, k, v = _qkv(xn, w_qkv, w_qn, w_kn)
    slopes = _alibi_slopes()
    outs, lses, rows = [], [], []
    for g, (window, dilation) in enumerate(GROUPS):
        buf = bufs[g]
        k_all = jnp.concatenate([buf[:, :, 0].astype(k.dtype), k[:, :, g]], axis=1)
        v_all = jnp.concatenate([buf[:, :, 1].astype(v.dtype), v[:, :, g]], axis=1)
        o, lse = _dilated_sample(q[:, :, g], k_all, v_all, window, dilation, slopes[g])
        outs.append(o)
        lses.append(lse)
        rows.append(jnp.stack([k[:, :, g], v[:, :, g]], axis=2))
    return _merge_groups(outs, lses).astype(xn.dtype) @ w_o, rows


def setup_inputs(seed: int = 0) -> dict:
    key = jax.random.key(seed)
    ks = jax.random.split(key, 24)
    f32 = jnp.float32

    def dense(k, shape, fan_in):
        return jax.random.normal(k, shape, f32) * (fan_in ** -0.5)

    def gain(k, shape):
        return 1.0 + 0.05 * jax.random.normal(k, shape, f32)

    def kv_cache(k, window):
        return jax.random.normal(k, (N_ATTN_LAYERS, DEC_BATCH, min(window, PAST_LEN), 2, ATT_HEADS, ATT_HEAD_DIM), f32)

    return {
        'x_prompt': jax.random.normal(ks[0], (BATCH, SEQ, D_MODEL), f32),
        'x_sample': jax.random.normal(ks[1], (DEC_BATCH, DEC_SEQ, D_MODEL), f32),
        'state_hgrn': jax.random.normal(ks[2], (N_HGRN_LAYERS, DEC_BATCH, HG_HEADS, HG_DK, HG_DV), f32),
        'cache_kv_w128': kv_cache(ks[3], GROUPS[0][0]),
        'cache_kv_w512': kv_cache(ks[4], GROUPS[1][0]),
        'cache_kv_w2048': kv_cache(ks[5], GROUPS[2][0]),
        'hg_lb_logits': 0.1 * jax.random.normal(ks[6], (DEPTH + 1, HG_WIDTH), f32),
        'hg_w_q': dense(ks[7], (N_HGRN_LAYERS, D_MODEL, HG_WIDTH), D_MODEL),
        'hg_w_f': dense(ks[8], (N_HGRN_LAYERS, D_MODEL, HG_WIDTH), D_MODEL),
        'hg_w_i': dense(ks[9], (N_HGRN_LAYERS, D_MODEL, HG_HEADS * HG_DV), D_MODEL),
        'hg_w_g': dense(ks[10], (N_HGRN_LAYERS, D_MODEL, HG_HEADS * HG_DV), D_MODEL),
        'hg_w_o': dense(ks[11], (N_HGRN_LAYERS, HG_HEADS * HG_DV, D_MODEL), HG_HEADS * HG_DV),
        'hg_norm_o': gain(ks[12], (N_HGRN_LAYERS, HG_HEADS * HG_DV)),
        'att_w_qkv': dense(ks[13], (N_ATTN_LAYERS, D_MODEL, 3 * N_GROUPS * ATT_WIDTH), D_MODEL),
        'att_w_o': dense(ks[14], (N_ATTN_LAYERS, ATT_WIDTH, D_MODEL), ATT_WIDTH),
        'att_q_norm': gain(ks[15], (N_ATTN_LAYERS, ATT_HEAD_DIM)),
        'att_k_norm': gain(ks[16], (N_ATTN_LAYERS, ATT_HEAD_DIM)),
        'norm_mix': gain(ks[17], (DEPTH, D_MODEL)),
        'norm_ffn': gain(ks[18], (DEPTH, D_MODEL)),
        'ffn_w_up': dense(ks[19], (DEPTH, D_MODEL, D_FF), D_MODEL),
        'ffn_w_down': dense(ks[20], (DEPTH, D_FF, D_MODEL), D_FF),
    }


def reference(x_prompt, x_sample, state_hgrn, cache_kv_w128, cache_kv_w512, cache_kv_w2048,
              hg_lb_logits, hg_w_q, hg_w_f, hg_w_i, hg_w_g, hg_w_o, hg_norm_o,
              att_w_qkv, att_w_o, att_q_norm, att_k_norm,
              norm_mix, norm_ffn, ffn_w_up, ffn_w_down):
    lb_all = jnp.cumsum(jax.nn.softmax(hg_lb_logits.astype(jnp.float32), axis=0), axis=0)
    yp, ys = x_prompt, x_sample
    hg_p, hg_s = [], []
    kv_p = [[] for _ in GROUPS]
    kv_s = [[] for _ in GROUPS]
    for layer in range(DEPTH):
        a = layer // N_MIXERS
        xnp = _rmsnorm(yp, norm_mix[layer])
        xns = _rmsnorm(ys, norm_mix[layer])
        if layer % N_MIXERS == 0:
            lw = (lb_all[layer], hg_w_q[a], hg_w_f[a], hg_w_i[a], hg_w_g[a], hg_w_o[a], hg_norm_o[a])
            s0p = jnp.zeros((yp.shape[0], HG_HEADS, HG_DK, HG_DV), jnp.float32)
            mp, sp = _hgrn_mixer(xnp, s0p, *lw)
            ms, ss = _hgrn_mixer(xns, state_hgrn[a], *lw)
            hg_p.append(sp)
            hg_s.append(ss)
        else:
            aw = (att_w_qkv[a], att_w_o[a], att_q_norm[a], att_k_norm[a])
            mp, rows_p = _attn_prompt(xnp, *aw)
            ms, rows_s = _attn_sample(xns, (cache_kv_w128[a], cache_kv_w512[a], cache_kv_w2048[a]), *aw)
            for g in range(N_GROUPS):
                kv_p[g].append(rows_p[g])
                kv_s[g].append(rows_s[g])
        yp = yp + mp.astype(yp.dtype)
        ys = ys + ms.astype(ys.dtype)
        yp = yp + _sqrelu_mlp(_rmsnorm(yp, norm_ffn[layer]), ffn_w_up[layer], ffn_w_down[layer]).astype(yp.dtype)
        ys = ys + _sqrelu_mlp(_rmsnorm(ys, norm_ffn[layer]), ffn_w_up[layer], ffn_w_down[layer]).astype(ys.dtype)
    return (yp, ys, jnp.stack(hg_p), jnp.stack(hg_s),
            jnp.stack(kv_p[0]), jnp.stack(kv_s[0]),
            jnp.stack(kv_p[1]), jnp.stack(kv_s[1]),
            jnp.stack(kv_p[2]), jnp.stack(kv_s[2]))
```

```cpp
#include <hip/hip_runtime.h>
#include <cstdio>
#include <cstdint>

#define GAS __attribute__((address_space(1)))
#define LAS __attribute__((address_space(3)))
typedef unsigned short bf16;
typedef unsigned v4u __attribute__((ext_vector_type(4)));
typedef unsigned v2u __attribute__((ext_vector_type(2)));
typedef float f32x4 __attribute__((ext_vector_type(4)));
typedef float f32x2 __attribute__((ext_vector_type(2)));
typedef short bf16x8 __attribute__((ext_vector_type(8)));
typedef short s16x4 __attribute__((ext_vector_type(4)));
typedef __bf16 bf16x2_t __attribute__((ext_vector_type(2)));
typedef GAS unsigned gu32;

#ifndef MK_PER_PHASE
#define MK_PER_PHASE 0
#endif

constexpr int MP = 16384, MS = 256, MT = MP + MS, DM = 1024, FF = 4096, NQKV = 9216, SEQ = 4096;
constexpr float EPS = 1e-6f;
constexpr float LOG2E = 1.4426950408889634f, LN2 = 0.6931471805599453f;
constexpr float QSCALE = 0.125f * LOG2E;
constexpr int NPHASE = 14;

constexpr size_t MiB = 1u << 20;
constexpr size_t WS_CTL = 0, CTL_ZERO_BYTES = 1 * MiB;
constexpr size_t WS_W1 = 4 * MiB, WS_WOH = 12 * MiB, WS_WUP0 = 14 * MiB, WS_WDN0 = 22 * MiB, WS_WQKV = 30 * MiB, WS_WOA = 48 * MiB, WS_WUP1 = 50 * MiB, WS_WDN1 = 58 * MiB;
constexpr size_t WS_XN = 66 * MiB;
constexpr size_t WS_QH = 99 * MiB, WS_VH = 132 * MiB, WS_GH = 165 * MiB, WS_LOGF = 198 * MiB;
constexpr size_t WS_Q2 = 263 * MiB, WS_OL = 296 * MiB, WS_A3 = 329 * MiB, WS_SL = 362 * MiB, WS_DT = 394 * MiB, WS_SS = 395 * MiB;
constexpr size_t WS_H = 99 * MiB;
constexpr size_t WS_QKV = 263 * MiB, QKV_STRIDE = 33 * MiB;
constexpr size_t WS_OG = 560 * MiB;
constexpr size_t WS_LSE = 659 * MiB;
constexpr size_t WS_OM = 663 * MiB;
constexpr size_t WS_END = 696 * MiB;
constexpr int CW_TMO = 0, CW_CODE = 1, CW_BAR = 4096;
constexpr int CW_RS = 65536;
constexpr int CW_LB = 200000;
static_assert((CW_RS + 5 * MT) < CW_LB && (CW_LB + 1024) * 4 <= (int)CTL_ZERO_BYTES, "ctl map");
constexpr size_t O_Y = 0, O_SHP = 17039360, O_SHS = 17563648, O_KV128P = 21757952, O_KV128S = 22806528, O_KV512P = 23330816, O_KV512S = 27525120,
                 O_KV2048P = 28049408, O_KV2048S = 44826624, O_END = 45350912;

__device__ __forceinline__ unsigned pk2(float lo, float hi) { f32x2 v = {lo, hi}; bf16x2_t b = __builtin_convertvector(v, bf16x2_t); return __builtin_bit_cast(unsigned, b); }
__device__ __forceinline__ float bf2f(unsigned short x) { return __uint_as_float((unsigned)x << 16); }
__device__ __forceinline__ float bflo(unsigned w) { return __uint_as_float(w << 16); }
__device__ __forceinline__ float bfhi(unsigned w) { return __uint_as_float(w & 0xffff0000u); }
__device__ __forceinline__ float wave_sum(float v) {
#pragma unroll
    for (int o = 1; o < 64; o <<= 1) v += __shfl_xor(v, o);
    return v;
}
__device__ __forceinline__ float fast_exp(float x) { return __builtin_amdgcn_exp2f(x * LOG2E); }
__device__ __forceinline__ float silu_f(float x) { return x / (1.f + fast_exp(-x)); }
#define LDS_WAIT() asm volatile("s_waitcnt lgkmcnt(0)" ::: "memory")
#define VM_WAIT() asm volatile("s_waitcnt vmcnt(0)" ::: "memory")
#define RLX_AGENT __ATOMIC_RELAXED, __HIP_MEMORY_SCOPE_AGENT

namespace pg8 {
#define PG8_LAS __attribute__((address_space(3)))
typedef unsigned short bf16_t;
constexpr int BM = 256, BK = 64, HALF = 128, HTB = HALF * BK * 2, STAGE_BYTES = 8 * HTB, NXCD = 8, WGM = 8;
__host__ __device__ __forceinline__ int lds_byte(int r, int c) { const int st = (r >> 4) * 2 + (c >> 5), rr = r & 15, cc = c & 31, ob = rr * 64 + cc * 2; return st * 1024 + (ob ^ (((ob >> 9) & 1) << 5)); }
__host__ __device__ __forceinline__ void stage_rc(int b, int& R, int& C) { const int st = b / 1024, sb = b % 1024, swz = sb ^ (((sb >> 9) & 1) << 5); R = (st >> 1) * 16 + swz / 64; C = (st & 1) * 32 + (swz % 64) / 2; }
struct Unit { int pm, pn; };
struct Gemm { const bf16_t* A; const bf16_t* Bt; int M, N, K; };
struct StaticOrder {
    int nM, nN, nwg, G, c;
    __host__ __device__ void init(int M, int N, int G_, int c_) { nM = M / BM; nN = N / BM; nwg = nM * nN; G = G_; c = c_; }
    __host__ __device__ bool next(int i, Unit& u) const {
        const long L = (long)i * G + c; if (L >= nwg) return false;
        int wgid = (int)L; { const int q = nwg / NXCD, r = nwg % NXCD, xcd = wgid % NXCD, off = wgid / NXCD; wgid = (xcd < r ? xcd * (q + 1) : r * (q + 1) + (xcd - r) * q) + off; }
        const int nig = WGM * nN, gid = wgid / nig, fm = gid * WGM, gsz = (nM - fm) < WGM ? (nM - fm) : WGM;
        u.pm = fm + ((wgid % nig) % gsz); u.pn = (wgid % nig) / gsz; return true;
    }
};
template <class Epi, class Sched>
__device__ __forceinline__ void gemm_phase(PG8_LAS unsigned char* lds, const Gemm g, const Sched& S, const Epi& E) {
    const int tid = threadIdx.x, wid = __builtin_amdgcn_readfirstlane(tid >> 6), lane = tid & 63, wr = wid >> 2, wc = wid & 3, fr = lane & 15, fq = lane >> 4;
    const int K = g.K, nt = K / BK;
    unsigned voffA[2];
#pragma unroll
    for (int i = 0; i < 2; ++i) { int R, C; stage_rc(tid * 16 + i * 8192, R, C); voffA[i] = (unsigned)(R * K + C) * 2u; }
    const size_t kstep = (size_t)(BK * 2);
    const size_t hstep = (size_t)HALF * K * 2;
    const size_t tstep = 2 * hstep;
    const unsigned ldsw = (unsigned)wid * 1024u;
    const int aoff = lds_byte(wr * 64 + fr, fq * 8), boff = lds_byte(wc * 32 + fr, fq * 8);
#define PG8_SA(b, h) (((b) * 2 + (h)) * HTB)
#define PG8_SB(b, h) ((4 + (b) * 2 + (h)) * HTB)
#define PG8_STAGE(bufoff, gbase, voff) do { _Pragma("unroll") for (int _i = 0; _i < 2; ++_i) \
        __builtin_amdgcn_global_load_lds((const unsigned*)((const char*)(gbase) + (voff)[_i]), (PG8_LAS unsigned*)(lds + (bufoff) + ldsw + _i * 8192), 16, 0, 0); } while (0)
#define PG8_LDA(dst, b, h) do { _Pragma("unroll") for (int m = 0; m < 4; ++m) _Pragma("unroll") for (int k = 0; k < 2; ++k) dst[m][k] = *(const PG8_LAS bf16x8*)(lds + PG8_SA(b, h) + aoff + m * 2048 + k * 1024); } while (0)
#define PG8_LDB(dst, b, h) do { _Pragma("unroll") for (int n = 0; n < 2; ++n) _Pragma("unroll") for (int k = 0; k < 2; ++k) dst[n][k] = *(const PG8_LAS bf16x8*)(lds + PG8_SB(b, h) + boff + n * 2048 + k * 1024); } while (0)
#define PG8_MMA(ai, bj, At, Bt) do { __builtin_amdgcn_s_setprio(1); _Pragma("unroll") for (int m = 0; m < 4; ++m) _Pragma("unroll") for (int n = 0; n < 2; ++n) _Pragma("unroll") for (int k = 0; k < 2; ++k) \
        acc[ai][bj][m][n] = __builtin_amdgcn_mfma_f32_16x16x32_bf16(Bt[n][k], At[m][k], acc[ai][bj][m][n], 0, 0, 0); __builtin_amdgcn_s_setprio(0); } while (0)
#define PG8_WAIT_V(n) asm volatile("s_waitcnt vmcnt(" #n ")" ::: "memory")
#define PG8_WAIT_L(n) asm volatile("s_waitcnt lgkmcnt(" #n ")" ::: "memory")
#define PG8_BAR __builtin_amdgcn_s_barrier()
#define PG8_SCHED __builtin_amdgcn_sched_barrier(0)
    Unit cur, nxt; int ui = 0;
    if (!S.next(0, cur)) return;
    f32x4 acc[2][2][4][2];
#pragma unroll
    for (int a = 0; a < 2; ++a)
#pragma unroll
        for (int b = 0; b < 2; ++b)
#pragma unroll
            for (int m = 0; m < 4; ++m)
#pragma unroll
                for (int n = 0; n < 2; ++n) acc[a][b][m][n] = (f32x4){0.f, 0.f, 0.f, 0.f};
    bf16x8 At[4][2], B0[2][2], B1[2][2];
    const char* cA = (const char*)g.A + (size_t)cur.pm * tstep; const char* cB = (const char*)g.Bt + (size_t)cur.pn * tstep;
    PG8_STAGE(PG8_SB(0, 0), cB, voffA); PG8_STAGE(PG8_SB(0, 1), cB + hstep, voffA); PG8_STAGE(PG8_SA(0, 0), cA, voffA); PG8_STAGE(PG8_SA(0, 1), cA + hstep, voffA);
    if (wr == 1) PG8_BAR;
    PG8_WAIT_V(2); PG8_BAR;
    PG8_STAGE(PG8_SB(1, 0), cB + kstep, voffA); PG8_STAGE(PG8_SA(1, 0), cA + kstep, voffA); PG8_STAGE(PG8_SB(1, 1), cB + hstep + kstep, voffA);
    PG8_WAIT_V(6); PG8_BAR;
    for (;;) {
        const bool has_next = S.next(ui + 1, nxt);
        const char* nA = has_next ? (const char*)g.A + (size_t)nxt.pm * tstep : cA; const char* nB = has_next ? (const char*)g.Bt + (size_t)nxt.pn * tstep : cB;
        for (int t = 0; t < nt; t += 2) {
            const bool last = (t == nt - 2);
            const char* a1 = cA + (size_t)(t + 1) * kstep;
            const char* a2 = last ? nA : cA + (size_t)(t + 2) * kstep; const char* b2 = last ? nB : cB + (size_t)(t + 2) * kstep;
            const char* a3 = a2 + kstep; const char* b3 = b2 + kstep;
            PG8_LDB(B0, 0, 0); PG8_LDB(B1, 0, 1); PG8_SCHED; PG8_LDA(At, 0, 0); PG8_STAGE(PG8_SA(1, 1), a1 + hstep, voffA);
            PG8_WAIT_V(8); PG8_WAIT_L(0); PG8_BAR; PG8_MMA(0, 0, At, B0); PG8_MMA(0, 1, At, B1); PG8_BAR; PG8_SCHED;
            PG8_LDA(At, 0, 1); PG8_STAGE(PG8_SB(0, 0), b2, voffA); PG8_STAGE(PG8_SB(0, 1), b2 + hstep, voffA); PG8_STAGE(PG8_SA(0, 0), a2, voffA);
            PG8_WAIT_V(8); PG8_WAIT_L(0); PG8_BAR; PG8_MMA(1, 0, At, B0); PG8_MMA(1, 1, At, B1); PG8_BAR; PG8_SCHED;
            PG8_LDB(B0, 1, 0); PG8_LDB(B1, 1, 1); PG8_SCHED; PG8_LDA(At, 1, 0); PG8_STAGE(PG8_SA(0, 1), a2 + hstep, voffA);
            PG8_WAIT_V(8); PG8_WAIT_L(0); PG8_BAR; PG8_MMA(0, 0, At, B0); PG8_MMA(0, 1, At, B1); PG8_BAR; PG8_SCHED;
            PG8_LDA(At, 1, 1); PG8_STAGE(PG8_SB(1, 0), b3, voffA); PG8_STAGE(PG8_SB(1, 1), b3 + hstep, voffA); PG8_STAGE(PG8_SA(1, 0), a3, voffA);
            PG8_WAIT_V(8); PG8_WAIT_L(0); PG8_BAR; PG8_MMA(1, 0, At, B0); PG8_MMA(1, 1, At, B1); PG8_BAR; PG8_SCHED;
        }
        if (wr == 0) PG8_BAR;
        E(acc, cur, wr, wc, fr, fq);
        if (!has_next) break;
#pragma unroll
        for (int a = 0; a < 2; ++a)
#pragma unroll
            for (int b = 0; b < 2; ++b)
#pragma unroll
                for (int m = 0; m < 4; ++m)
#pragma unroll
                    for (int n = 0; n < 2; ++n) acc[a][b][m][n] = (f32x4){0.f, 0.f, 0.f, 0.f};
        cur = nxt; cA = nA; cB = nB; ++ui;
        if (wr == 1) PG8_BAR;
    }
    PG8_WAIT_V(0);
    PG8_BAR;
#undef PG8_SA
#undef PG8_SB
#undef PG8_STAGE
#undef PG8_LDA
#undef PG8_LDB
#undef PG8_MMA
#undef PG8_WAIT_V
#undef PG8_WAIT_L
#undef PG8_BAR
#undef PG8_SCHED
}
}

__host__ __device__ __forceinline__ int perm32inv(int c) { return 16 * ((c >> 2) & 1) + 4 * (c >> 3) + (c & 3); }
__host__ __device__ __forceinline__ int phys_row(int c, int mode) {
    if (mode == 0) return (c & ~31) + perm32inv(c & 31);
    const int tile = c >> 8, w = c & 255, wc = w >> 6, bj = (w >> 5) & 1;
    return tile * 256 + 128 * bj + 32 * wc + perm32inv(w & 31);
}

#define XB_TMO      128
#define XB_XCNT(j)  (256  + 64 * (j))
#define XB_XSUB(j)  (1280 + 64 * (j))
#define XB_XGEN(j)  (2304 + 64 * (j))
#define XB_TOP      3328
#define XB_TOPGEN   3392
#define XCD_BAR_WORDS 3456
#define XB_SPIN_CAP (1u << 20)
__device__ __forceinline__ unsigned xb_ld(unsigned* p)              { return __hip_atomic_load(p, __ATOMIC_RELAXED, __HIP_MEMORY_SCOPE_AGENT); }
__device__ __forceinline__ unsigned xb_add(unsigned* p, unsigned v) { return __hip_atomic_fetch_add(p, v, __ATOMIC_RELAXED, __HIP_MEMORY_SCOPE_AGENT); }
__device__ __forceinline__ unsigned xb_xcc_id() { return (unsigned)__builtin_amdgcn_s_getreg((3 << 11) | 20) & 0xFu; }
#define XB_SPIN(cond, bar) do { unsigned _sp = 0; while (cond) { __builtin_amdgcn_s_sleep(1); \
    if ((++_sp & 255u) == 0u) { if (xb_ld(&(bar)[XB_TMO])) break; if (_sp > XB_SPIN_CAP) { atomicAdd(&(bar)[XB_TMO], 1u); break; } } } } while (0)
struct XcdBarrier { unsigned* bar; unsigned x; volatile LAS unsigned* st; };
__device__ __forceinline__ XcdBarrier xcd_barrier_post(unsigned* bar, volatile LAS unsigned* st) {
    XcdBarrier b; b.bar = bar; b.x = xb_xcc_id(); b.st = st;
    if (threadIdx.x == 0) (void)xb_add(&bar[XB_XCNT(b.x)], 1u);
    return b;
}
__device__ __forceinline__ void xcd_barrier_complete(unsigned* bar, unsigned x, unsigned& nloc, unsigned& nx) {
    const unsigned G = gridDim.x * gridDim.y * gridDim.z;
    unsigned sum, cnt, mine, sp = 0u;
    for (;;) {
        sum = 0u; cnt = 0u; mine = 0u;
#pragma unroll
        for (unsigned j = 0; j < 16; ++j) { const unsigned c = xb_ld(&bar[XB_XCNT(j)]); sum += c; cnt += (c > 0u) ? 1u : 0u; mine = (j == x) ? c : mine; }
        if (sum == G) break;
        __builtin_amdgcn_s_sleep(1);
        if ((++sp & 255u) == 0u) { if (xb_ld(&bar[XB_TMO])) break; if (sp > XB_SPIN_CAP) { atomicAdd(&bar[XB_TMO], 1u); break; } }
    }
    nloc = mine > 0u ? mine : 1u; nx = cnt > 0u ? cnt : 1u;
}
__device__ __forceinline__ void xcd_barrier(const XcdBarrier& b) {
    asm volatile("s_waitcnt vmcnt(0)" ::: "memory");
    __syncthreads();
    if (threadIdx.x == 0) {
        unsigned* bar = b.bar;
        __builtin_amdgcn_s_waitcnt(0);
        unsigned nloc = b.st[0], nx = b.st[1];
        if (nloc == 0u) { xcd_barrier_complete(bar, b.x, nloc, nx); b.st[0] = nloc; b.st[1] = nx; }
        const unsigned old = xb_add(&bar[XB_XSUB(b.x)], 1u);
        const unsigned gen = old / nloc;
        if (old + 1u == (gen + 1u) * nloc) {
            __builtin_amdgcn_fence(__ATOMIC_RELEASE, "agent");
            asm volatile("s_waitcnt vmcnt(0)" ::: "memory");
            const unsigned og = xb_add(&bar[XB_TOP], 1u);
            const unsigned tg = og / nx;
            if (og + 1u == (tg + 1u) * nx) xb_add(&bar[XB_TOPGEN], 1u);
            else XB_SPIN(xb_ld(&bar[XB_TOPGEN]) == tg, bar);
            __builtin_amdgcn_fence(__ATOMIC_ACQUIRE, "agent");
            xb_add(&bar[XB_XGEN(b.x)], 1u);
            asm volatile("s_waitcnt vmcnt(0)" ::: "memory");
        } else {
            XB_SPIN(xb_ld(&bar[XB_XGEN(b.x)]) == gen, bar);
            __builtin_amdgcn_fence(__ATOMIC_ACQUIRE, "agent");
            asm volatile("s_waitcnt vmcnt(0)" ::: "memory");
        }
    }
    __syncthreads();
}

constexpr int RING_BYTES = 131072;
constexpr int LDSCTL_OFF = RING_BYTES, MISC_OFF = LDSCTL_OFF + 320;
constexpr int LDS_BYTES = 147456;

struct Args { const float* in[21]; float* out; unsigned char* ws; int ph_lo, ph_hi; };
struct Frame {
    LAS unsigned char* lds;
    int tid, lane, wave, G, bid;
    const float* const* in; float* out; unsigned char* ws; float* ctlf;
};
#define WSP(T, off) ((T*)(F.ws + (off)))
__device__ __forceinline__ const float* xrow_ptr(const Frame& F, int row) { return row < MP ? F.in[0] + (size_t)row * DM : F.in[1] + (size_t)(row - MP) * DM; }

__device__ __forceinline__ void p0_transpose_item(const float* W, int K, int N, const float* scale, bf16* WT, int row_off, int mode, LAS float* scr, int item, int lane) {
    const int nblk = N / 32, kb = item / nblk, nb = item % nblk, k0 = 64 * kb, n0 = 32 * nb;
#pragma unroll 8
    for (int i = 0; i < 32; ++i) { const int kk = 2 * i + (lane >> 5); const float s = scale ? scale[k0 + kk] : 1.f; scr[kk * 33 + (lane & 31)] = W[(size_t)(k0 + kk) * N + n0 + (lane & 31)] * s; }
    LDS_WAIT(); asm volatile("" ::: "memory");
    const int c = lane & 7;
#pragma unroll
    for (int j = 0; j < 4; ++j) { const int n = (lane >> 3) + 8 * j; const LAS float* s = scr + (8 * c) * 33 + n;
        v4u o; o.x = pk2(s[0 * 33], s[1 * 33]); o.y = pk2(s[2 * 33], s[3 * 33]); o.z = pk2(s[4 * 33], s[5 * 33]); o.w = pk2(s[6 * 33], s[7 * 33]);
        *(GAS v4u*)(WT + (size_t)(row_off + phys_row(n0 + n, mode)) * K + k0 + 8 * c) = o; }
    LDS_WAIT(); asm volatile("" ::: "memory");
}
__device__ __forceinline__ void p0_prologue(Frame& F) {
    LAS float* scr = (LAS float*)(F.lds + F.wave * 16384);
    const int gw = F.bid * 8 + F.wave, NGW = F.G * 8;
    const float* nmix = F.in[17]; const float* nffn = F.in[18];
    constexpr int I_SQ = 16 * 32, I_UP = 16 * 128, I_DN = 64 * 32, I_QKV = 16 * 288;
    constexpr int NITEMS = 4 * I_SQ + I_SQ + I_UP + I_DN + I_QKV + I_SQ + I_UP + I_DN;
    for (int it = gw; it < NITEMS; it += NGW) {
        int r = it;
        if (r < 4 * I_SQ) { const int w = r / I_SQ; p0_transpose_item(F.in[7 + w], DM, DM, nmix, WSP(bf16, WS_W1), w * DM, 0, scr, r % I_SQ, F.lane); continue; } r -= 4 * I_SQ;
        if (r < I_SQ) { p0_transpose_item(F.in[11], DM, DM, F.in[12], WSP(bf16, WS_WOH), 0, 0, scr, r, F.lane); continue; } r -= I_SQ;
        if (r < I_UP) { p0_transpose_item(F.in[19], DM, FF, nffn, WSP(bf16, WS_WUP0), 0, 0, scr, r, F.lane); continue; } r -= I_UP;
        if (r < I_DN) { p0_transpose_item(F.in[20], FF, DM, nullptr, WSP(bf16, WS_WDN0), 0, 0, scr, r, F.lane); continue; } r -= I_DN;
        if (r < I_QKV) { p0_transpose_item(F.in[13], DM, NQKV, nmix + DM, WSP(bf16, WS_WQKV), 0, 1, scr, r, F.lane); continue; } r -= I_QKV;
        if (r < I_SQ) { p0_transpose_item(F.in[14], DM, DM, nullptr, WSP(bf16, WS_WOA), 0, 0, scr, r, F.lane); continue; } r -= I_SQ;
        if (r < I_UP) { p0_transpose_item(F.in[19] + (size_t)DM * FF, DM, FF, nffn + DM, WSP(bf16, WS_WUP1), 0, 0, scr, r, F.lane); continue; } r -= I_UP;
        p0_transpose_item(F.in[20] + (size_t)FF * DM, FF, DM, nullptr, WSP(bf16, WS_WDN1), 0, 0, scr, r, F.lane);
    }
    bf16* XN = WSP(bf16, WS_XN); float* rs0 = F.ctlf + CW_RS;
    for (int m = gw; m < MT; m += NGW) {
        const GAS f32x4* xr = (const GAS f32x4*)xrow_ptr(F, m) + F.lane;
        f32x4 v[4]; float s = 0.f;
#pragma unroll
        for (int j = 0; j < 4; ++j) { v[j] = xr[64 * j]; s += (v[j].x * v[j].x + v[j].y * v[j].y) + (v[j].z * v[j].z + v[j].w * v[j].w); }
        s = wave_sum(s);
        GAS v2u* o8 = (GAS v2u*)(XN + (size_t)m * DM) + F.lane;
#pragma unroll
        for (int j = 0; j < 4; ++j) o8[64 * j] = (v2u){pk2(v[j].x, v[j].y), pk2(v[j].z, v[j].w)};
        if (F.lane == 0) rs0[m] = s;
    }
    { const int gt = F.bid * 512 + F.tid; if (gt < 1024) { const float* lg = F.in[6]; const float a = lg[gt], b = lg[1024 + gt], c = lg[2048 + gt]; const float mx = fmaxf(a, fmaxf(b, c));
        const float ea = expf(a - mx), eb = expf(b - mx), ec = expf(c - mx); F.ctlf[CW_LB + gt] = ea / (ea + eb + ec); } }
}

__device__ __forceinline__ float rstd_of(const float* rs, int row) { return rsqrtf(rs[row] * (1.f / DM) + EPS); }
__device__ __forceinline__ void st_bf8(bf16* p, const f32x4 a, const f32x4 b) { *(GAS v4u*)p = (v4u){pk2(a.x, a.y), pk2(a.z, a.w), pk2(b.x, b.y), pk2(b.z, b.w)}; }
__device__ __forceinline__ float sq4(const f32x4 a) { return (a.x * a.x + a.y * a.y) + (a.z * a.z + a.w * a.w); }
__device__ __forceinline__ void row_atomic(float* rs, int row, float s, int fq) { s += __shfl_xor(s, 16); s += __shfl_xor(s, 32); if (fq == 0) atomicAdd(rs + row, s); }

struct RowE1 {
    const float* rs; const float* lb; bf16* QH; float* LOGF; bf16* VH; bf16* GH;
    __device__ __forceinline__ void row(int row, int pn, int wc, int fq, f32x4 a00, f32x4 a01, f32x4 a10, f32x4 a11) const {
        const float r = rstd_of(rs, row); const int blk = pn >> 2;
#pragma unroll
        for (int bj = 0; bj < 2; ++bj) {
            f32x4 u = (bj ? a10 : a00) * r, v = (bj ? a11 : a01) * r;
            const int cc = ((pn & 3) << 8) + 128 * bj + 32 * wc + 8 * fq; const size_t off = (size_t)row * DM + cc;
            if (blk == 0) {
#pragma unroll
                for (int j = 0; j < 4; ++j) { u[j] = silu_f(u[j]); v[j] = silu_f(v[j]); }
                st_bf8(QH + off, u, v);
            } else if (blk == 1) {
                const f32x4 l0 = *(const f32x4*)(lb + cc), l1 = *(const f32x4*)(lb + cc + 4);
#pragma unroll
                for (int j = 0; j < 4; ++j) { const float s0 = 1.f / (1.f + fast_exp(-u[j])), s1 = 1.f / (1.f + fast_exp(-v[j])); u[j] = __logf(l0[j] + (1.f - l0[j]) * s0); v[j] = __logf(l1[j] + (1.f - l1[j]) * s1); }
                *(GAS f32x4*)(LOGF + off) = u; *(GAS f32x4*)(LOGF + off + 4) = v;
            } else if (blk == 2) {
                st_bf8(VH + off, u, v);
            } else {
#pragma unroll
                for (int j = 0; j < 4; ++j) { u[j] = silu_f(u[j]); v[j] = silu_f(v[j]); }
                st_bf8(GH + off, u, v);
            }
        }
    }
};
struct RowERes {
    const float* rs_in;
    const float* xp; const float* xs;
    float* Y; bf16* XN; float* rs_out;
    __device__ __forceinline__ void row(int row, int pn, int wc, int fq, f32x4 a00, f32x4 a01, f32x4 a10, f32x4 a11) const {
        const float r = rs_in ? rstd_of(rs_in, row) : 1.f;
        const float* base = xp ? (row < MP ? xp + (size_t)row * DM : xs + (size_t)(row - MP) * DM) : Y + (size_t)row * DM;
        float ss = 0.f;
#pragma unroll
        for (int bj = 0; bj < 2; ++bj) {
            const int cc = (pn << 8) + 128 * bj + 32 * wc + 8 * fq; const size_t off = (size_t)row * DM + cc;
            const f32x4 b0 = *(const GAS f32x4*)(base + cc), b1 = *(const GAS f32x4*)(base + cc + 4);
            const f32x4 u = b0 + (bj ? a10 : a00) * r, v = b1 + (bj ? a11 : a01) * r;
            *(GAS f32x4*)(Y + off) = u; *(GAS f32x4*)(Y + off + 4) = v;
            if (XN) st_bf8(XN + off, u, v);
            ss += sq4(u) + sq4(v);
        }
        if (rs_out) row_atomic(rs_out, row, ss, fq);
    }
};
struct RowEUp {
    const float* rs; bf16* H;
    __device__ __forceinline__ void row(int row, int pn, int wc, int fq, f32x4 a00, f32x4 a01, f32x4 a10, f32x4 a11) const {
        const float r = rstd_of(rs, row);
#pragma unroll
        for (int bj = 0; bj < 2; ++bj) {
            f32x4 u = (bj ? a10 : a00) * r, v = (bj ? a11 : a01) * r;
#pragma unroll
            for (int j = 0; j < 4; ++j) { const float p = fmaxf(u[j], 0.f), q = fmaxf(v[j], 0.f); u[j] = p * p; v[j] = q * q; }
            st_bf8(H + (size_t)row * FF + (pn << 8) + 128 * bj + 32 * wc + 8 * fq, u, v);
        }
    }
};
struct RowEQkv {
    const float* rs; const float* qn; const float* kn; unsigned char* qkv_base; float* out;
    __device__ __forceinline__ void row(int row, int pn, int wc, int fq, f32x4 a00, f32x4 a01, f32x4 a10, f32x4 a11) const {
        const float r = rstd_of(rs, row);
        const int which = pn / 12, g = (pn >> 2) % 3, h = 4 * (pn & 3) + wc;
        f32x4 v[2][2] = {{a00 * r, a01 * r}, {a10 * r, a11 * r}};
        if (which < 2) {
            float ss = sq4(v[0][0]) + sq4(v[0][1]) + sq4(v[1][0]) + sq4(v[1][1]);
            ss += __shfl_xor(ss, 16); ss += __shfl_xor(ss, 32);
            float sc = rsqrtf(ss * (1.f / 64.f) + EPS); if (which == 0) sc *= QSCALE;
            const float* wn = which == 0 ? qn : kn;
#pragma unroll
            for (int bj = 0; bj < 2; ++bj)
#pragma unroll
                for (int n = 0; n < 2; ++n) { const f32x4 w = *(const f32x4*)(wn + 32 * bj + 8 * fq + 4 * n); v[bj][n] = v[bj][n] * w * sc; }
        }
        int arow = row, b, t = 0; const bool prompt = row < MP;
        const int dsh = 2 * g;
        if (prompt) { b = row >> 12; t = row & 4095; arow = (b << 12) + ((t & ((1 << dsh) - 1)) << (12 - dsh)) + (t >> dsh); } else { b = (row - MP) >> 3; }
        bf16* dst = (bf16*)(qkv_base + (size_t)(which * 3 + g) * QKV_STRIDE) + (size_t)arow * DM + h * 64 + 8 * fq;
        st_bf8(dst, v[0][0], v[0][1]); st_bf8(dst + 32, v[1][0], v[1][1]);
        if (which >= 1) {
            const int W = 128 << (2 * g);
            float* o = nullptr;
            if (prompt) { if (t >= SEQ - W) o = out + (g == 0 ? O_KV128P : g == 1 ? O_KV512P : O_KV2048P) + ((size_t)(b * W + (t - (SEQ - W))) * 2 + (which - 1)) * 1024; }
            else o = out + (g == 0 ? O_KV128S : g == 1 ? O_KV512S : O_KV2048S) + ((size_t)(row - MP) * 2 + (which - 1)) * 1024;
            if (o) { o += h * 64 + 8 * fq;
                *(GAS f32x4*)(o) = v[0][0]; *(GAS f32x4*)(o + 4) = v[0][1]; *(GAS f32x4*)(o + 32) = v[1][0]; *(GAS f32x4*)(o + 36) = v[1][1]; }
        }
    }
};
template <class RowEpi> struct EpiWrap {
    RowEpi R;
    __device__ __forceinline__ void operator()(const f32x4 (&acc)[2][2][4][2], const pg8::Unit& u, int wr, int wc, int fr, int fq) const {
#pragma unroll
        for (int ai = 0; ai < 2; ++ai)
#pragma unroll
            for (int m = 0; m < 4; ++m) R.row(u.pm * 256 + ai * 128 + wr * 64 + m * 16 + fr, u.pn, wc, fq, acc[ai][0][m][0], acc[ai][0][m][1], acc[ai][1][m][0], acc[ai][1][m][1]);
    }
};

template <class RowEpi>
__device__ __forceinline__ void small_gemm(Frame& F, const bf16* A  , const bf16* Bt, int N, int K, const RowEpi& R) {
    const int lane = F.lane, fr = lane & 15, fq = lane >> 4, w = F.wave;
    const int nunits = 8 * (N / 64), kw = K / 8;
    LAS f32x4* part = (LAS f32x4*)F.lds;
    for (int u = F.bid; u < nunits; u += F.G) {
        const int rb = u & 7, cg = u >> 3, pn = cg >> 2, wc = cg & 3;
        f32x4 acc[2][2][2];
#pragma unroll
        for (int m = 0; m < 2; ++m)
#pragma unroll
            for (int bj = 0; bj < 2; ++bj)
#pragma unroll
                for (int n = 0; n < 2; ++n) acc[m][bj][n] = (f32x4){0.f, 0.f, 0.f, 0.f};
        const bf16* ap = A + (size_t)(rb * 32 + fr) * K + w * kw + 8 * fq;
        const bf16* bp = Bt + (size_t)(pn * 256 + 32 * wc + fr) * K + w * kw + 8 * fq;
#pragma unroll 4
        for (int k = 0; k < kw; k += 32) {
            bf16x8 a[2], b[2][2];
#pragma unroll
            for (int m = 0; m < 2; ++m) a[m] = *(const GAS bf16x8*)(ap + (size_t)(16 * m) * K + k);
#pragma unroll
            for (int bj = 0; bj < 2; ++bj)
#pragma unroll
                for (int n = 0; n < 2; ++n) b[bj][n] = *(const GAS bf16x8*)(bp + (size_t)(128 * bj + 16 * n) * K + k);
#pragma unroll
            for (int m = 0; m < 2; ++m)
#pragma unroll
                for (int bj = 0; bj < 2; ++bj)
#pragma unroll
                    for (int n = 0; n < 2; ++n) acc[m][bj][n] = __builtin_amdgcn_mfma_f32_16x16x32_bf16(b[bj][n], a[m], acc[m][bj][n], 0, 0, 0);
        }
#pragma unroll
        for (int m = 0; m < 2; ++m)
#pragma unroll
            for (int bj = 0; bj < 2; ++bj)
#pragma unroll
                for (int n = 0; n < 2; ++n) part[(w * 8 + m * 4 + bj * 2 + n) * 64 + lane] = acc[m][bj][n];
        __syncthreads();
        if (w < 2) {
            f32x4 s[2][2];
#pragma unroll
            for (int bj = 0; bj < 2; ++bj)
#pragma unroll
                for (int n = 0; n < 2; ++n) { f32x4 t = (f32x4){0.f, 0.f, 0.f, 0.f};
#pragma unroll
                    for (int ww = 0; ww < 8; ++ww) t += part[(ww * 8 + w * 4 + bj * 2 + n) * 64 + lane];
                    s[bj][n] = t; }
            R.row(MP + rb * 32 + 16 * w + fr, pn, wc, fq, s[0][0], s[0][1], s[1][0], s[1][1]);
        }
        __syncthreads();
    }
}

__device__ __forceinline__ bf16x8 ldfrag(const LAS unsigned char* base, int row, int pitch, int ks, int g) { return *(const LAS bf16x8*)(base + row * pitch + ks * 64 + g * 16); }
#define MFMA16(a, b, c) __builtin_amdgcn_mfma_f32_16x16x32_bf16((a), (b), (c), 0, 0, 0)

constexpr int H_QP = 0, H_KP = 17408, H_KT = 34816, H_VT = 53248, H_PM = 71680, H_ST = 80896, H_TOT = 115712, H_DV = 117760;
constexpr int P272 = 272, P144 = 144;
__device__ __forceinline__ void hgrn_b1(Frame& F) {
    const bf16* QH = WSP(bf16, WS_QH); const bf16* VH = WSP(bf16, WS_VH); const float* LOGF = WSP(float, WS_LOGF);
    bf16* Q2 = WSP(bf16, WS_Q2); bf16* OL = WSP(bf16, WS_OL); float* SL = WSP(float, WS_SL); float* DT = WSP(float, WS_DT);
    LAS unsigned char* L = F.lds;
    const int tid = F.tid, lane = F.lane, w = F.wave, r = lane & 15, g = lane >> 4;
    const int col = tid & 127, qr = tid >> 7;
    LAS float* TOT = (LAS float*)(L + H_TOT); LAS float* DV = (LAS float*)(L + H_DV);
    for (int it = F.bid; it < 512; it += F.G) {
        const int bh = it >> 4, j = it & 15, b = bh >> 3, h = bh & 7;
        const size_t grow0 = (size_t)b * SEQ + j * 256;
        float base = 0.f;
        f32x4 accS[8];
#pragma unroll
        for (int i = 0; i < 8; ++i) accS[i] = (f32x4){0.f, 0.f, 0.f, 0.f};
        for (int c = 0; c < 4; ++c) {
            const size_t e0 = (grow0 + c * 64 + qr * 16) * DM + h * 128 + col;
            float lf[16]; unsigned short qv[16], vv[16];
#pragma unroll
            for (int i = 0; i < 16; ++i) { lf[i] = LOGF[e0 + (size_t)i * DM]; qv[i] = QH[e0 + (size_t)i * DM]; vv[i] = VH[e0 + (size_t)i * DM]; }
            float cum[16]; float run = 0.f;
#pragma unroll
            for (int i = 0; i < 16; ++i) { run += lf[i]; cum[i] = run; }
            TOT[qr * 128 + col] = run;
            __syncthreads();
            float offs = 0.f, last = 0.f;
#pragma unroll
            for (int q = 0; q < 4; ++q) { const float tq = TOT[q * 128 + col]; if (q < qr) offs += tq; last += tq; }
            unsigned ktw[8], vtw[8];
#pragma unroll
            for (int i = 0; i < 16; ++i) {
                const float cv = cum[i] + offs, q = bf2f(qv[i]);
                const float kk = 1.f - fast_exp(lf[i]);
                const float qp = q * fast_exp(cv), kp = kk * fast_exp(-cv), k2 = kk * fast_exp(last - cv), q2 = q * fast_exp(cv + base);
                const int t = qr * 16 + i;
                *(LAS unsigned short*)(L + H_QP + t * P272 + col * 2) = (unsigned short)pk2(qp, 0.f);
                *(LAS unsigned short*)(L + H_KP + t * P272 + col * 2) = (unsigned short)pk2(kp, 0.f);
                Q2[e0 + (size_t)i * DM] = (unsigned short)pk2(q2, 0.f);
                const unsigned kb = pk2(k2, 0.f) & 0xffffu;
                if (i & 1) { ktw[i >> 1] |= kb << 16; vtw[i >> 1] |= (unsigned)vv[i] << 16; } else { ktw[i >> 1] = kb; vtw[i >> 1] = vv[i]; }
            }
            *(LAS v4u*)(L + H_KT + col * P144 + qr * 32) = (v4u){ktw[0], ktw[1], ktw[2], ktw[3]};
            *(LAS v4u*)(L + H_KT + col * P144 + qr * 32 + 16) = (v4u){ktw[4], ktw[5], ktw[6], ktw[7]};
            *(LAS v4u*)(L + H_VT + col * P144 + qr * 32) = (v4u){vtw[0], vtw[1], vtw[2], vtw[3]};
            *(LAS v4u*)(L + H_VT + col * P144 + qr * 32 + 16) = (v4u){vtw[4], vtw[5], vtw[6], vtw[7]};
            if (qr == 0) DV[col] = fast_exp(last);
            base += last;
            __syncthreads();
            {
                const int tm = w & 3;
#pragma unroll
                for (int i = 0; i < 2; ++i) {
                    const int tn = 2 * (w >> 2) + i;
                    f32x4 a = (f32x4){0.f, 0.f, 0.f, 0.f};
                    if (tn <= tm) {
#pragma unroll
                        for (int ks = 0; ks < 4; ++ks) a = MFMA16(ldfrag(L + H_KP, 16 * tn + r, P272, ks, g), ldfrag(L + H_QP, 16 * tm + r, P272, ks, g), a);
                        if (tn == tm) {
#pragma unroll
                            for (int e = 0; e < 4; ++e) if (4 * g + e > r) a[e] = 0.f;
                        }
                    }
                    *(LAS v2u*)(L + H_PM + (16 * tm + r) * P144 + (16 * tn + 4 * g) * 2) = (v2u){pk2(a[0], a[1]), pk2(a[2], a[3])};
                }
            }
            __syncthreads();
            {
                const int tm = w & 3;
#pragma unroll
                for (int i = 0; i < 4; ++i) {
                    const int tn = 4 * (w >> 2) + i;
                    f32x4 a = (f32x4){0.f, 0.f, 0.f, 0.f};
#pragma unroll
                    for (int ks = 0; ks < 2; ++ks) a = MFMA16(ldfrag(L + H_VT, 16 * tn + r, P144, ks, g), ldfrag(L + H_PM, 16 * tm + r, P144, ks, g), a);
                    if (c > 0) {
#pragma unroll
                        for (int ks = 0; ks < 4; ++ks) a = MFMA16(ldfrag(L + H_ST, 16 * tn + r, P272, ks, g), ldfrag(L + H_QP, 16 * tm + r, P272, ks, g), a);
                    }
                    *(GAS v2u*)(OL + (grow0 + c * 64 + 16 * tm + r) * DM + h * 128 + 16 * tn + 4 * g) = (v2u){pk2(a[0], a[1]), pk2(a[2], a[3])};
                }
            }
            __syncthreads();
#pragma unroll
            for (int tk = 0; tk < 8; ++tk) {
                const f32x4 d = *(const LAS f32x4*)(DV + 16 * tk + 4 * g);
                f32x4 a = accS[tk] * d;
#pragma unroll
                for (int ks = 0; ks < 2; ++ks) a = MFMA16(ldfrag(L + H_KT, 16 * tk + r, P144, ks, g), ldfrag(L + H_VT, 16 * w + r, P144, ks, g), a);
                accS[tk] = a;
                *(LAS v2u*)(L + H_ST + (16 * w + r) * P272 + (16 * tk + 4 * g) * 2) = (v2u){pk2(a[0], a[1]), pk2(a[2], a[3])};
            }
            __syncthreads();
        }
#pragma unroll
        for (int tk = 0; tk < 8; ++tk) *(GAS f32x4*)(SL + (size_t)it * 16384 + (16 * w + r) * 128 + 16 * tk + 4 * g) = accS[tk];
        if (qr == 0) DT[it * 128 + col] = fast_exp(base);
    }
}
__device__ __forceinline__ void hgrn_sample(Frame& F) {
    const bf16* QH = WSP(bf16, WS_QH); const bf16* VH = WSP(bf16, WS_VH); const bf16* GH = WSP(bf16, WS_GH); const float* LOGF = WSP(float, WS_LOGF);
    bf16* A3 = WSP(bf16, WS_A3); float* rso = F.ctlf + CW_RS + MT;
    const float* S0 = F.in[2]; float* SO = F.out + O_SHS;
    LAS float* qs = (LAS float*)F.lds; LAS float* fs = qs + 1024; LAS float* vs = fs + 1024; LAS float* gs = vs + 1024; LAS float* red = gs + 1024;
    const int tid = F.tid, v = tid & 127, kq = tid >> 7;
    for (int it = F.bid; it < 256; it += F.G) {
        const int b = it >> 3, h = it & 7;
        __syncthreads();
        for (int e = tid; e < 1024; e += 512) { const int t = e >> 7, c = e & 127; const size_t off = (size_t)(MP + b * 8 + t) * DM + h * 128 + c;
            qs[e] = bf2f(QH[off]); fs[e] = fast_exp(LOGF[off]); vs[e] = bf2f(VH[off]); gs[e] = bf2f(GH[off]); }
        float S[32];
        const size_t sb = ((size_t)it * 128 + 32 * kq) * 128 + v;
#pragma unroll
        for (int i = 0; i < 32; ++i) S[i] = S0[sb + (size_t)i * 128];
        __syncthreads();
#pragma unroll 1
        for (int t = 0; t < 8; ++t) {
            const float vt = vs[t * 128 + v]; float po = 0.f;
#pragma unroll
            for (int i = 0; i < 32; ++i) { const float fk = fs[t * 128 + 32 * kq + i]; S[i] = fk * S[i] + (1.f - fk) * vt; po += qs[t * 128 + 32 * kq + i] * S[i]; }
            red[(t * 4 + kq) * 128 + v] = po;
        }
#pragma unroll
        for (int i = 0; i < 32; ++i) SO[sb + (size_t)i * 128] = S[i];
        __syncthreads();
        { const int t = F.wave; float ss = 0.f; const int row = MP + b * 8 + t;
#pragma unroll
            for (int hh = 0; hh < 2; ++hh) { const int vv = F.lane + 64 * hh; const float o = (red[(t * 4 + 0) * 128 + vv] + red[(t * 4 + 1) * 128 + vv]) + (red[(t * 4 + 2) * 128 + vv] + red[(t * 4 + 3) * 128 + vv]);
                ss += o * o; A3[(size_t)row * DM + h * 128 + vv] = (unsigned short)pk2(o * gs[t * 128 + vv], 0.f); }
            ss = wave_sum(ss); if (F.lane == 0) atomicAdd(rso + row, ss); }
    }
    __syncthreads();
}
__device__ __forceinline__ void hgrn_scan(Frame& F) {
    const float* SL = WSP(float, WS_SL); const float* DT = WSP(float, WS_DT); bf16* SS = WSP(bf16, WS_SS); float* SHP = F.out + O_SHP;
    for (int idx = F.bid * 512 + F.tid; idx < 32 * 128 * 32; idx += F.G * 512) {
        const int bh = idx >> 12, v = (idx >> 5) & 127, k = (idx & 31) * 4;
        f32x4 s = (f32x4){0.f, 0.f, 0.f, 0.f};
#pragma unroll 4
        for (int j = 0; j < 16; ++j) { const int it = bh * 16 + j;
            *(GAS v2u*)(SS + (size_t)it * 16384 + v * 128 + k) = (v2u){pk2(s.x, s.y), pk2(s.z, s.w)};
            const f32x4 d = *(const GAS f32x4*)(DT + it * 128 + k), sl = *(const GAS f32x4*)(SL + (size_t)it * 16384 + v * 128 + k);
            s = d * s + sl; }
#pragma unroll
        for (int e = 0; e < 4; ++e) SHP[(size_t)bh * 16384 + (k + e) * 128 + v] = s[e];
    }
}
constexpr int B3_Q = 0, B3_S = 69632;
__device__ __forceinline__ void hgrn_b3(Frame& F) {
    const bf16* Q2 = WSP(bf16, WS_Q2); const bf16* OL = WSP(bf16, WS_OL); const bf16* GH = WSP(bf16, WS_GH); const bf16* SS = WSP(bf16, WS_SS);
    bf16* A3 = WSP(bf16, WS_A3); float* rso = F.ctlf + CW_RS + MT;
    LAS unsigned char* L = F.lds; const int tid = F.tid, lane = F.lane, w = F.wave, r = lane & 15, g = lane >> 4;
    for (int it = F.bid; it < 512; it += F.G) {
        const int bh = it >> 4, j = it & 15, b = bh >> 3, h = bh & 7; const size_t grow0 = (size_t)b * SEQ + j * 256;
        __syncthreads();
#pragma unroll
        for (int i = 0; i < 8; ++i) { const int ch = tid + 512 * i, row = ch >> 4, c16 = ch & 15; *(LAS v4u*)(L + B3_Q + row * P272 + c16 * 16) = *(const GAS v4u*)(Q2 + (grow0 + row) * DM + h * 128 + c16 * 8); }
#pragma unroll
        for (int i = 0; i < 4; ++i) { const int ch = tid + 512 * i, row = ch >> 4, c16 = ch & 15; *(LAS v4u*)(L + B3_S + row * P272 + c16 * 16) = *(const GAS v4u*)(SS + (size_t)it * 16384 + row * 128 + c16 * 8); }
        __syncthreads();
#pragma unroll
        for (int mi = 0; mi < 2; ++mi) {
            const int t = 32 * w + 16 * mi + r; const size_t rowoff = (grow0 + t) * DM + h * 128;
            bf16x8 qa[4];
#pragma unroll
            for (int ks = 0; ks < 4; ++ks) qa[ks] = ldfrag(L + B3_Q, t, P272, ks, g);
            float ss = 0.f;
#pragma unroll
            for (int tn = 0; tn < 8; ++tn) {
                f32x4 a = (f32x4){0.f, 0.f, 0.f, 0.f};
#pragma unroll
                for (int ks = 0; ks < 4; ++ks) a = MFMA16(ldfrag(L + B3_S, 16 * tn + r, P272, ks, g), qa[ks], a);
                const v2u ol = *(const GAS v2u*)(OL + rowoff + 16 * tn + 4 * g), gg = *(const GAS v2u*)(GH + rowoff + 16 * tn + 4 * g);
                const float o0 = a[0] + bflo(ol.x), o1 = a[1] + bfhi(ol.x), o2 = a[2] + bflo(ol.y), o3 = a[3] + bfhi(ol.y);
                ss += (o0 * o0 + o1 * o1) + (o2 * o2 + o3 * o3);
                *(GAS v2u*)(A3 + rowoff + 16 * tn + 4 * g) = (v2u){pk2(o0 * bflo(gg.x), o1 * bfhi(gg.x)), pk2(o2 * bflo(gg.y), o3 * bfhi(gg.y))};
            }
            ss += __shfl_xor(ss, 16); ss += __shfl_xor(ss, 32);
            if (g == 0) atomicAdd(rso + grow0 + t, ss);
        }
    }
    __syncthreads();
}

constexpr int AT_K = 0, AT_V = 36864, AT_VROWS = 272;
__device__ __forceinline__ s16x4 tr16(const LAS unsigned char* p) { return __builtin_bit_cast(s16x4, __builtin_amdgcn_ds_read_tr16_b64_v4i16((LAS s16x4*)p)); }
__device__ __forceinline__ float alibi_slope2(int g, int h) { return exp2f(-8.f * (float)(g * 16 + h + 1) / 48.f) * LOG2E; }
__device__ __forceinline__ void attn_prompt(Frame& F) {
    LAS unsigned char* L = F.lds; const int tid = F.tid, lane = F.lane, w = F.wave, r = lane & 15, g4 = lane >> 4;
    float* LSE = WSP(float, WS_LSE);
    for (int e = tid; e < 16 * P144 / 4; e += 512) *(LAS unsigned*)(L + AT_V + 256 * P144 + e * 4) = 0u;
    for (int it = F.bid; it < 6144; it += F.G) {
        const int grp = it / 2048, rem = it % 2048;
        const int dsh = 2 * grp, Lq = 4096 >> dsh, nqt = Lq >> 7;
        const int qt = rem % nqt, hs = rem / nqt, h = hs & 15, seq = hs >> 4;
        const size_t seqbase = (size_t)seq * Lq;
        const bf16* Qg = (const bf16*)(F.ws + WS_QKV + (size_t)(0 * 3 + grp) * QKV_STRIDE);
        const bf16* Kg = (const bf16*)(F.ws + WS_QKV + (size_t)(1 * 3 + grp) * QKV_STRIDE);
        const bf16* Vg = (const bf16*)(F.ws + WS_QKV + (size_t)(2 * 3 + grp) * QKV_STRIDE);
        bf16* Og = (bf16*)(F.ws + WS_OG + (size_t)grp * QKV_STRIDE);
        const int q0 = qt * 128;
        __syncthreads();
#pragma unroll
        for (int i = 0; i < 4; ++i) { const int ch = tid + 512 * i, row = ch >> 3, c8 = ch & 7; const int kp = q0 - 128 + row;
            v4u kv = (v4u){0u, 0u, 0u, 0u}, vv = (v4u){0u, 0u, 0u, 0u};
            if (kp >= 0) { const size_t off = (seqbase + kp) * DM + h * 64 + c8 * 8; kv = *(const GAS v4u*)(Kg + off); vv = *(const GAS v4u*)(Vg + off); }
            *(LAS v4u*)(L + AT_K + row * P144 + c8 * 16) = kv; *(LAS v4u*)(L + AT_V + row * P144 + c8 * 16) = vv; }
        const int qw0 = q0 + 16 * w;
        bf16x8 qf[2];
#pragma unroll
        for (int ks = 0; ks < 2; ++ks) qf[ks] = *(const GAS bf16x8*)(Qg + (seqbase + qw0 + r) * DM + h * 64 + 32 * ks + 8 * g4);
        __syncthreads();
        const float sl2 = alibi_slope2(grp, h) * (float)(1 << dsh);
        f32x4 st[10];
#pragma unroll
        for (int T = 0; T < 9; ++T) {
            f32x4 a = (f32x4){0.f, 0.f, 0.f, 0.f};
#pragma unroll
            for (int ks = 0; ks < 2; ++ks) a = MFMA16(ldfrag(L + AT_K, 16 * w + 16 * T + r, P144, ks, g4), qf[ks], a);
            st[T] = a;
        }
        float mx = -INFINITY;
#pragma unroll
        for (int T = 0; T < 9; ++T)
#pragma unroll
            for (int e = 0; e < 4; ++e) { const int iw = 16 * T + 4 * g4 + e, dist = r + 128 - iw; const bool ok = dist >= 0 && dist <= 128 && (qw0 - 128 + iw) >= 0;
                const float x = ok ? st[T][e] - sl2 * (float)dist : -INFINITY; st[T][e] = x; mx = fmaxf(mx, x); }
        mx = fmaxf(mx, __shfl_xor(mx, 16)); mx = fmaxf(mx, __shfl_xor(mx, 32));
        float lsum = 0.f;
#pragma unroll
        for (int T = 0; T < 9; ++T)
#pragma unroll
            for (int e = 0; e < 4; ++e) { const float p = __builtin_amdgcn_exp2f(st[T][e] - mx); st[T][e] = p; lsum += p; }
        st[9] = (f32x4){0.f, 0.f, 0.f, 0.f};
        lsum += __shfl_xor(lsum, 16); lsum += __shfl_xor(lsum, 32);
        f32x4 oa[4];
#pragma unroll
        for (int dt = 0; dt < 4; ++dt) oa[dt] = (f32x4){0.f, 0.f, 0.f, 0.f};
#pragma unroll
        for (int u = 0; u < 5; ++u) {
            const v4u pw = (v4u){pk2(st[2 * u][0], st[2 * u][1]), pk2(st[2 * u][2], st[2 * u][3]), pk2(st[2 * u + 1][0], st[2 * u + 1][1]), pk2(st[2 * u + 1][2], st[2 * u + 1][3])};
            const bf16x8 pf = __builtin_bit_cast(bf16x8, pw);
#pragma unroll
            for (int dt = 0; dt < 4; ++dt) {
                const LAS unsigned char* vb = L + AT_V + (16 * w + 32 * u + 4 * g4 + (r >> 2)) * P144 + (16 * dt + 4 * (r & 3)) * 2;
                const s16x4 lo = tr16(vb), hi = tr16(vb + 16 * P144);
                const bf16x8 vf = (bf16x8){lo[0], lo[1], lo[2], lo[3], hi[0], hi[1], hi[2], hi[3]};
                oa[dt] = MFMA16(vf, pf, oa[dt]);
            }
        }
        const float inv = 1.f / lsum;
        const int m = qw0 + r, res = seq & ((1 << dsh) - 1), b = seq >> dsh;
        const size_t nrow = (size_t)b * SEQ + ((size_t)m << dsh) + res;
#pragma unroll
        for (int dt = 0; dt < 4; ++dt) *(GAS v2u*)(Og + nrow * DM + h * 64 + 16 * dt + 4 * g4) = (v2u){pk2(oa[dt][0] * inv, oa[dt][1] * inv), pk2(oa[dt][2] * inv, oa[dt][3] * inv)};
        if (g4 == 0) LSE[((size_t)grp * MT + nrow) * 16 + h] = (mx + __log2f(lsum)) * LN2;
    }
    __syncthreads();
}
__device__ __forceinline__ void attn_sample(Frame& F) {
    const int lane = F.lane, ksub = lane >> 4, dc = lane & 15, w = F.wave;
    float* LSE = WSP(float, WS_LSE);
    for (int it = F.bid; it < 768; it += F.G) {
        const int s = it & 7, grp = (it >> 3) % 3, b = it / 24;
        const int dsh = 2 * grp, W = 128 << dsh, dil = 1 << dsh;
        const float* cache = F.in[3 + grp] + (size_t)b * W * 2048;
        const float* newkv = F.out + (grp == 0 ? O_KV128S : grp == 1 ? O_KV512S : O_KV2048S) + (size_t)b * 8 * 2048;
        const bf16* Qg = (const bf16*)(F.ws + WS_QKV + (size_t)grp * QKV_STRIDE);
        bf16* Og = (bf16*)(F.ws + WS_OG + (size_t)grp * QKV_STRIDE);
        const size_t row = (size_t)MP + b * 8 + s;
#pragma unroll 1
        for (int hh = 0; hh < 2; ++hh) {
            const int h = 2 * w + hh;
            const v2u qw = *(const GAS v2u*)(Qg + row * DM + h * 64 + 4 * dc);
            const f32x4 q = (f32x4){bflo(qw.x), bfhi(qw.x), bflo(qw.y), bfhi(qw.y)};
            const float sl2 = alibi_slope2(grp, h) * (float)dil;
            float mx = -INFINITY, lsum = 0.f; f32x4 o = (f32x4){0.f, 0.f, 0.f, 0.f};
#pragma unroll 1
            for (int j0 = 0; j0 < 132; j0 += 32) {
                f32x4 kx[8], vx[8];
#pragma unroll
                for (int i = 0; i < 8; ++i) { int j = j0 + 4 * i + ksub; if (j > 128) j = 128; const int idx = W + s - dil * j;
                    const float* rp = idx >= W ? newkv + (size_t)(idx - W) * 2048 : cache + (size_t)idx * 2048;
                    kx[i] = *(const GAS f32x4*)(rp + h * 64 + 4 * dc); vx[i] = *(const GAS f32x4*)(rp + 1024 + h * 64 + 4 * dc); }
                float sc[8]; float bm = -INFINITY;
#pragma unroll
                for (int i = 0; i < 8; ++i) { const int j = j0 + 4 * i + ksub;
                    float d = (kx[i].x * q.x + kx[i].y * q.y) + (kx[i].z * q.z + kx[i].w * q.w);
                    d += __shfl_xor(d, 1); d += __shfl_xor(d, 2); d += __shfl_xor(d, 4); d += __shfl_xor(d, 8);
                    sc[i] = j <= 128 ? d - sl2 * (float)j : -INFINITY; bm = fmaxf(bm, sc[i]); }
                bm = fmaxf(bm, __shfl_xor(bm, 16)); bm = fmaxf(bm, __shfl_xor(bm, 32));
                const float nm = fmaxf(mx, bm), f = __builtin_amdgcn_exp2f(mx - nm);
                lsum *= f; o = o * f; mx = nm;
#pragma unroll
                for (int i = 0; i < 8; ++i) { const float p = __builtin_amdgcn_exp2f(sc[i] - mx); lsum += p; o += vx[i] * p; }
            }
            lsum += __shfl_xor(lsum, 16); lsum += __shfl_xor(lsum, 32);
#pragma unroll
            for (int e = 0; e < 4; ++e) { o[e] += __shfl_xor(o[e], 16); o[e] += __shfl_xor(o[e], 32); }
            const float inv = 1.f / lsum;
            if (ksub == 0) *(GAS v2u*)(Og + row * DM + h * 64 + 4 * dc) = (v2u){pk2(o[0] * inv, o[1] * inv), pk2(o[2] * inv, o[3] * inv)};
            if (lane == 0) LSE[((size_t)grp * MT + row) * 16 + h] = (mx + __log2f(lsum)) * LN2;
        }
    }
}
__device__ __forceinline__ void attn_merge(Frame& F) {
    const float* LSE = WSP(float, WS_LSE); bf16* OM = WSP(bf16, WS_OM);
    for (int idx = F.bid * 512 + F.tid; idx < MT * 128; idx += F.G * 512) {
        const int row = idx >> 7, c8 = idx & 127, h = c8 >> 3;
        const float l0 = LSE[((size_t)0 * MT + row) * 16 + h], l1 = LSE[((size_t)1 * MT + row) * 16 + h], l2 = LSE[((size_t)2 * MT + row) * 16 + h];
        const float mx = fmaxf(l0, fmaxf(l1, l2)); const float e0 = __expf(l0 - mx), e1 = __expf(l1 - mx), e2 = __expf(l2 - mx); const float inv = 1.f / (e0 + e1 + e2);
        const float wgt[3] = {e0 * inv, e1 * inv, e2 * inv};
        float acc[8] = {0.f, 0.f, 0.f, 0.f, 0.f, 0.f, 0.f, 0.f};
#pragma unroll
        for (int gi = 0; gi < 3; ++gi) { const v4u x = *(const GAS v4u*)((const bf16*)(F.ws + WS_OG + (size_t)gi * QKV_STRIDE) + (size_t)row * DM + c8 * 8);
            acc[0] += wgt[gi] * bflo(x.x); acc[1] += wgt[gi] * bfhi(x.x); acc[2] += wgt[gi] * bflo(x.y); acc[3] += wgt[gi] * bfhi(x.y);
            acc[4] += wgt[gi] * bflo(x.z); acc[5] += wgt[gi] * bfhi(x.z); acc[6] += wgt[gi] * bflo(x.w); acc[7] += wgt[gi] * bfhi(x.w); }
        *(GAS v4u*)(OM + (size_t)row * DM + c8 * 8) = (v4u){pk2(acc[0], acc[1]), pk2(acc[2], acc[3]), pk2(acc[4], acc[5]), pk2(acc[6], acc[7])};
    }
}

template <class RowEpi>
__device__ __forceinline__ void run_gemm(Frame& F, const bf16* A, const bf16* Bt, int N, int K, const RowEpi& R) {
    pg8::Gemm gm{A, Bt, MP, N, K}; pg8::StaticOrder S; S.init(MP, N, F.G, F.bid);
    EpiWrap<RowEpi> E{R};
    pg8::gemm_phase<EpiWrap<RowEpi>, pg8::StaticOrder>(F.lds, gm, S, E);
    small_gemm<RowEpi>(F, A + (size_t)MP * K, Bt, N, K, R);
}

__global__ void __launch_bounds__(512, 2) mega_fwd(Args args) {
    extern __shared__ __attribute__((aligned(16))) unsigned char lds_raw[];
    Frame F;
    F.lds = (LAS unsigned char*)lds_raw;
    F.tid = threadIdx.x; F.lane = F.tid & 63; F.wave = __builtin_amdgcn_readfirstlane(F.tid >> 6);
    F.G = gridDim.x; F.bid = blockIdx.x;
    F.in = args.in; F.out = args.out; F.ws = args.ws; F.ctlf = (float*)(args.ws + WS_CTL);
    unsigned* ctl = (unsigned*)(args.ws + WS_CTL);
    for (int u = F.tid; u < (LDS_BYTES - LDSCTL_OFF) / 4; u += 512) ((LAS unsigned*)(F.lds + LDSCTL_OFF))[u] = 0u;
    __syncthreads();
    XcdBarrier bar; bar.bar = ctl + CW_BAR; bar.x = 0; bar.st = nullptr;
    if (!MK_PER_PHASE) bar = xcd_barrier_post(ctl + CW_BAR, (volatile LAS unsigned*)(F.lds + MISC_OFF) + 8);
    const int lo = args.ph_lo, hi = args.ph_hi;
#define IN(k) (lo <= (k) && (k) < hi)
#define SEAM(k) do { if (IN(k) && IN((k) + 1)) xcd_barrier(bar); } while (0)
    float* rs = F.ctlf + CW_RS;
    if (IN(0)) { p0_prologue(F); } SEAM(0);
    if (IN(1)) { RowE1 R{rs, F.ctlf + CW_LB, WSP(bf16, WS_QH), WSP(float, WS_LOGF), WSP(bf16, WS_VH), WSP(bf16, WS_GH)}; run_gemm(F, WSP(bf16, WS_XN), WSP(bf16, WS_W1), 4096, 1024, R); } SEAM(1);
    if (IN(2)) { hgrn_b1(F); hgrn_sample(F); } SEAM(2);
    if (IN(3)) { hgrn_scan(F); } SEAM(3);
    if (IN(4)) { hgrn_b3(F); } SEAM(4);
    if (IN(5)) { RowERes R{rs + MT, F.in[0], F.in[1], F.out + O_Y, WSP(bf16, WS_XN), rs + 2 * MT}; run_gemm(F, WSP(bf16, WS_A3), WSP(bf16, WS_WOH), 1024, 1024, R); } SEAM(5);
    if (IN(6)) { RowEUp R{rs + 2 * MT, WSP(bf16, WS_H)}; run_gemm(F, WSP(bf16, WS_XN), WSP(bf16, WS_WUP0), 4096, 1024, R); } SEAM(6);
    if (IN(7)) { RowERes R{nullptr, nullptr, nullptr, F.out + O_Y, WSP(bf16, WS_XN), rs + 3 * MT}; run_gemm(F, WSP(bf16, WS_H), WSP(bf16, WS_WDN0), 1024, 4096, R); } SEAM(7);
    if (IN(8)) { RowEQkv R{rs + 3 * MT, F.in[15], F.in[16], F.ws + WS_QKV, F.out}; run_gemm(F, WSP(bf16, WS_XN), WSP(bf16, WS_WQKV), NQKV, 1024, R); } SEAM(8);
    if (IN(9)) { attn_sample(F); attn_prompt(F); } SEAM(9);
    if (IN(10)) { attn_merge(F); } SEAM(10);
    if (IN(11)) { RowERes R{nullptr, nullptr, nullptr, F.out + O_Y, WSP(bf16, WS_XN), rs + 4 * MT}; run_gemm(F, WSP(bf16, WS_OM), WSP(bf16, WS_WOA), 1024, 1024, R); } SEAM(11);
    if (IN(12)) { RowEUp R{rs + 4 * MT, WSP(bf16, WS_H)}; run_gemm(F, WSP(bf16, WS_XN), WSP(bf16, WS_WUP1), 4096, 1024, R); } SEAM(12);
    if (IN(13)) { RowERes R{nullptr, nullptr, nullptr, F.out + O_Y, nullptr, nullptr}; run_gemm(F, WSP(bf16, WS_H), WSP(bf16, WS_WDN1), 1024, 4096, R); }
#undef IN
#undef SEAM
}

extern "C" void kernel_launch(void* const* d_in, const int* in_sizes, int n_in, void* d_out, int out_size, void* d_ws, size_t ws_size, hipStream_t stream) {
    static int grid = 0;
    if (grid == 0) {
        if (n_in != 21 || in_sizes[0] != MP * DM || (size_t)out_size != O_END || ws_size < WS_END) {
            fprintf(stderr, "kernel_launch: unexpected shapes: n_in %d in0 %d out %d ws %zu (need %zu); nothing launched\n", n_in, n_in > 0 ? in_sizes[0] : -1, out_size, ws_size, (size_t)WS_END); grid = -1; return; }
        int dev = 0, cus = 0, per_cu = 0;
        if (hipGetDevice(&dev) != hipSuccess || hipDeviceGetAttribute(&cus, hipDeviceAttributeMultiprocessorCount, dev) != hipSuccess) { fprintf(stderr, "kernel_launch: device query failed\n"); grid = -1; return; }
        if (hipFuncSetAttribute((const void*)mega_fwd, hipFuncAttributeMaxDynamicSharedMemorySize, LDS_BYTES) != hipSuccess) { fprintf(stderr, "kernel_launch: hipFuncSetAttribute failed\n"); grid = -1; return; }
        if (hipOccupancyMaxActiveBlocksPerMultiprocessor(&per_cu, (const void*)mega_fwd, 512, LDS_BYTES) != hipSuccess || per_cu < 1) { fprintf(stderr, "kernel_launch: occupancy query says %d blocks per CU\n", per_cu); (void)hipGetLastError(); grid = -1; return; }
        grid = cus;
    }
    if (grid < 0) return;
    (void)hipMemsetAsync((char*)d_ws + WS_CTL, 0, CTL_ZERO_BYTES, stream);
    Args a{};
    for (int i = 0; i < 21; ++i) a.in[i] = (const float*)d_in[i];
    a.out = (float*)d_out; a.ws = (unsigned char*)d_ws;
#if MK_PER_PHASE
    for (int p = 0; p < NPHASE; ++p) { a.ph_lo = p; a.ph_hi = p + 1; hipLaunchKernelGGL(mega_fwd, dim3(grid), dim3(512), LDS_BYTES, stream, a); }
#else
    a.ph_lo = 0; a.ph_hi = NPHASE;
    hipLaunchKernelGGL(mega_fwd, dim3(grid), dim3(512), LDS_BYTES, stream, a);
#endif
}
```

```cpp
#include <hip/hip_runtime.h>
#include <cstdio>
#include <cstdint>

#define GAS __attribute__((address_space(1)))
#define LAS __attribute__((address_space(3)))
typedef unsigned short bf16;
typedef unsigned v4u __attribute__((ext_vector_type(4)));
typedef unsigned v2u __attribute__((ext_vector_type(2)));
typedef float f32x4 __attribute__((ext_vector_type(4)));
typedef float f32x2 __attribute__((ext_vector_type(2)));
typedef short bf16x8 __attribute__((ext_vector_type(8)));
typedef short s16x4 __attribute__((ext_vector_type(4)));
typedef __bf16 bf16x2_t __attribute__((ext_vector_type(2)));
typedef GAS unsigned gu32;

#ifndef PROBE_DUP
#define PROBE_DUP 0u
#endif
#ifndef MK_PER_PHASE
#define MK_PER_PHASE 0
#endif

constexpr int MP = 16384, MS = 256, MT = MP + MS, DM = 1024, FF = 4096, NQKV = 9216, SEQ = 4096;
constexpr float EPS = 1e-6f;
constexpr float LOG2E = 1.4426950408889634f, LN2 = 0.6931471805599453f;
constexpr float QSCALE = 0.125f * LOG2E;
constexpr int NPHASE = 14;

constexpr size_t MiB = 1u << 20;
constexpr size_t WS_CTL = 0, CTL_ZERO_BYTES = 1 * MiB;
constexpr size_t WS_W1 = 4 * MiB, WS_WOH = 12 * MiB, WS_WUP0 = 14 * MiB, WS_WDN0 = 22 * MiB, WS_WQKV = 30 * MiB, WS_WOA = 48 * MiB, WS_WUP1 = 50 * MiB, WS_WDN1 = 58 * MiB;
constexpr size_t WS_XN = 66 * MiB;
constexpr size_t WS_QH = 99 * MiB, WS_VH = 132 * MiB, WS_GH = 165 * MiB, WS_LOGF = 198 * MiB;
constexpr size_t WS_Q2 = 263 * MiB, WS_OL = 296 * MiB, WS_A3 = 329 * MiB, WS_SL = 362 * MiB, WS_DT = 394 * MiB, WS_SS = 395 * MiB;
constexpr size_t WS_H = 99 * MiB;
constexpr size_t WS_QKV = 263 * MiB, QKV_STRIDE = 33 * MiB;
constexpr size_t WS_OG = 560 * MiB;
constexpr size_t WS_LSE = 659 * MiB;
constexpr size_t WS_OM = 663 * MiB;
constexpr size_t WS_END = 696 * MiB;
constexpr int CW_TMO = 0, CW_CODE = 1, CW_BAR = 4096;
constexpr int CW_RS = 65536;
constexpr int CW_LB = 200000;
static_assert((CW_RS + 5 * MT) < CW_LB && (CW_LB + 1024) * 4 <= (int)CTL_ZERO_BYTES, "ctl map");
constexpr size_t O_Y = 0, O_SHP = 17039360, O_SHS = 17563648, O_KV128P = 21757952, O_KV128S = 22806528, O_KV512P = 23330816, O_KV512S = 27525120,
                 O_KV2048P = 28049408, O_KV2048S = 44826624, O_END = 45350912;

__device__ __forceinline__ unsigned pk2(float lo, float hi) { f32x2 v = {lo, hi}; bf16x2_t b = __builtin_convertvector(v, bf16x2_t); return __builtin_bit_cast(unsigned, b); }
__device__ __forceinline__ float bf2f(unsigned short x) { return __uint_as_float((unsigned)x << 16); }
__device__ __forceinline__ float bflo(unsigned w) { return __uint_as_float(w << 16); }
__device__ __forceinline__ float bfhi(unsigned w) { return __uint_as_float(w & 0xffff0000u); }
__device__ __forceinline__ float wave_sum(float v) {
#pragma unroll
    for (int o = 1; o < 64; o <<= 1) v += __shfl_xor(v, o);
    return v;
}
__device__ __forceinline__ float fast_exp(float x) { return __builtin_amdgcn_exp2f(x * LOG2E); }
__device__ __forceinline__ float silu_f(float x) { return x / (1.f + fast_exp(-x)); }
#define LDS_WAIT() asm volatile("s_waitcnt lgkmcnt(0)" ::: "memory")
#define VM_WAIT() asm volatile("s_waitcnt vmcnt(0)" ::: "memory")
#define RLX_AGENT __ATOMIC_RELAXED, __HIP_MEMORY_SCOPE_AGENT

namespace pg8 {
#define PG8_LAS __attribute__((address_space(3)))
typedef unsigned short bf16_t;
constexpr int BM = 256, BK = 64, HALF = 128, HTB = HALF * BK * 2, STAGE_BYTES = 8 * HTB, NXCD = 8, WGM = 8;
__host__ __device__ __forceinline__ int lds_byte(int r, int c) { const int st = (r >> 4) * 2 + (c >> 5), rr = r & 15, cc = c & 31, ob = rr * 64 + cc * 2; return st * 1024 + (ob ^ (((ob >> 9) & 1) << 5)); }
__host__ __device__ __forceinline__ void stage_rc(int b, int& R, int& C) { const int st = b / 1024, sb = b % 1024, swz = sb ^ (((sb >> 9) & 1) << 5); R = (st >> 1) * 16 + swz / 64; C = (st & 1) * 32 + (swz % 64) / 2; }
struct Unit { int pm, pn; };
struct Gemm { const bf16_t* A; const bf16_t* Bt; int M, N, K; };
struct StaticOrder {
    int nM, nN, nwg, G, c;
    __host__ __device__ void init(int M, int N, int G_, int c_) { nM = M / BM; nN = N / BM; nwg = nM * nN; G = G_; c = c_; }
    __host__ __device__ bool next(int i, Unit& u) const {
        const long L = (long)i * G + c; if (L >= nwg) return false;
        int wgid = (int)L; { const int q = nwg / NXCD, r = nwg % NXCD, xcd = wgid % NXCD, off = wgid / NXCD; wgid = (xcd < r ? xcd * (q + 1) : r * (q + 1) + (xcd - r) * q) + off; }
        const int nig = WGM * nN, gid = wgid / nig, fm = gid * WGM, gsz = (nM - fm) < WGM ? (nM - fm) : WGM;
        u.pm = fm + ((wgid % nig) % gsz); u.pn = (wgid % nig) / gsz; return true;
    }
};
template <class Epi, class Sched>
__device__ __forceinline__ void gemm_phase(PG8_LAS unsigned char* lds, const Gemm g, const Sched& S, const Epi& E) {
    const int tid = threadIdx.x, wid = __builtin_amdgcn_readfirstlane(tid >> 6), lane = tid & 63, wr = wid >> 2, wc = wid & 3, fr = lane & 15, fq = lane >> 4;
    const int K = g.K, nt = K / BK;
    unsigned voffA[2];
#pragma unroll
    for (int i = 0; i < 2; ++i) { int R, C; stage_rc(tid * 16 + i * 8192, R, C); voffA[i] = (unsigned)(R * K + C) * 2u; }
    const size_t kstep = (size_t)(BK * 2);
    const size_t hstep = (size_t)HALF * K * 2;
    const size_t tstep = 2 * hstep;
    const unsigned ldsw = (unsigned)wid * 1024u;
    const int aoff = lds_byte(wr * 64 + fr, fq * 8), boff = lds_byte(wc * 32 + fr, fq * 8);
#define PG8_SA(b, h) (((b) * 2 + (h)) * HTB)
#define PG8_SB(b, h) ((4 + (b) * 2 + (h)) * HTB)
#define PG8_STAGE(bufoff, gbase, voff) do { _Pragma("unroll") for (int _i = 0; _i < 2; ++_i) \
        __builtin_amdgcn_global_load_lds((const unsigned*)((const char*)(gbase) + (voff)[_i]), (PG8_LAS unsigned*)(lds + (bufoff) + ldsw + _i * 8192), 16, 0, 0); } while (0)
#define PG8_LDA(dst, b, h) do { _Pragma("unroll") for (int m = 0; m < 4; ++m) _Pragma("unroll") for (int k = 0; k < 2; ++k) dst[m][k] = *(const PG8_LAS bf16x8*)(lds + PG8_SA(b, h) + aoff + m * 2048 + k * 1024); } while (0)
#define PG8_LDB(dst, b, h) do { _Pragma("unroll") for (int n = 0; n < 2; ++n) _Pragma("unroll") for (int k = 0; k < 2; ++k) dst[n][k] = *(const PG8_LAS bf16x8*)(lds + PG8_SB(b, h) + boff + n * 2048 + k * 1024); } while (0)
#define PG8_MMA(ai, bj, At, Bt) do { __builtin_amdgcn_s_setprio(1); _Pragma("unroll") for (int m = 0; m < 4; ++m) _Pragma("unroll") for (int n = 0; n < 2; ++n) _Pragma("unroll") for (int k = 0; k < 2; ++k) \
        acc[ai][bj][m][n] = __builtin_amdgcn_mfma_f32_16x16x32_bf16(Bt[n][k], At[m][k], acc[ai][bj][m][n], 0, 0, 0); __builtin_amdgcn_s_setprio(0); } while (0)
#define PG8_WAIT_V(n) asm volatile("s_waitcnt vmcnt(" #n ")" ::: "memory")
#define PG8_WAIT_L(n) asm volatile("s_waitcnt lgkmcnt(" #n ")" ::: "memory")
#define PG8_BAR __builtin_amdgcn_s_barrier()
#define PG8_SCHED __builtin_amdgcn_sched_barrier(0)
    Unit cur, nxt; int ui = 0;
    if (!S.next(0, cur)) return;
    f32x4 acc[2][2][4][2];
#pragma unroll
    for (int a = 0; a < 2; ++a)
#pragma unroll
        for (int b = 0; b < 2; ++b)
#pragma unroll
            for (int m = 0; m < 4; ++m)
#pragma unroll
                for (int n = 0; n < 2; ++n) acc[a][b][m][n] = (f32x4){0.f, 0.f, 0.f, 0.f};
    bf16x8 At[4][2], B0[2][2], B1[2][2];
    const char* cA = (const char*)g.A + (size_t)cur.pm * tstep; const char* cB = (const char*)g.Bt + (size_t)cur.pn * tstep;
    PG8_STAGE(PG8_SB(0, 0), cB, voffA); PG8_STAGE(PG8_SB(0, 1), cB + hstep, voffA); PG8_STAGE(PG8_SA(0, 0), cA, voffA); PG8_STAGE(PG8_SA(0, 1), cA + hstep, voffA);
    if (wr == 1) PG8_BAR;
    PG8_WAIT_V(2); PG8_BAR;
    PG8_STAGE(PG8_SB(1, 0), cB + kstep, voffA); PG8_STAGE(PG8_SA(1, 0), cA + kstep, voffA); PG8_STAGE(PG8_SB(1, 1), cB + hstep + kstep, voffA);
    PG8_WAIT_V(6); PG8_BAR;
    for (;;) {
        const bool has_next = S.next(ui + 1, nxt);
        const char* nA = has_next ? (const char*)g.A + (size_t)nxt.pm * tstep : cA; const char* nB = has_next ? (const char*)g.Bt + (size_t)nxt.pn * tstep : cB;
        for (int t = 0; t < nt; t += 2) {
            const bool last = (t == nt - 2);
            const char* a1 = cA + (size_t)(t + 1) * kstep;
            const char* a2 = last ? nA : cA + (size_t)(t + 2) * kstep; const char* b2 = last ? nB : cB + (size_t)(t + 2) * kstep;
            const char* a3 = a2 + kstep; const char* b3 = b2 + kstep;
            PG8_LDB(B0, 0, 0); PG8_LDB(B1, 0, 1); PG8_SCHED; PG8_LDA(At, 0, 0); PG8_STAGE(PG8_SA(1, 1), a1 + hstep, voffA);
            PG8_WAIT_V(8); PG8_WAIT_L(0); PG8_BAR; PG8_MMA(0, 0, At, B0); PG8_MMA(0, 1, At, B1); PG8_BAR; PG8_SCHED;
            PG8_LDA(At, 0, 1); PG8_STAGE(PG8_SB(0, 0), b2, voffA); PG8_STAGE(PG8_SB(0, 1), b2 + hstep, voffA); PG8_STAGE(PG8_SA(0, 0), a2, voffA);
            PG8_WAIT_V(8); PG8_WAIT_L(0); PG8_BAR; PG8_MMA(1, 0, At, B0); PG8_MMA(1, 1, At, B1); PG8_BAR; PG8_SCHED;
            PG8_LDB(B0, 1, 0); PG8_LDB(B1, 1, 1); PG8_SCHED; PG8_LDA(At, 1, 0); PG8_STAGE(PG8_SA(0, 1), a2 + hstep, voffA);
            PG8_WAIT_V(8); PG8_WAIT_L(0); PG8_BAR; PG8_MMA(0, 0, At, B0); PG8_MMA(0, 1, At, B1); PG8_BAR; PG8_SCHED;
            PG8_LDA(At, 1, 1); PG8_STAGE(PG8_SB(1, 0), b3, voffA); PG8_STAGE(PG8_SB(1, 1), b3 + hstep, voffA); PG8_STAGE(PG8_SA(1, 0), a3, voffA);
            PG8_WAIT_V(8); PG8_WAIT_L(0); PG8_BAR; PG8_MMA(1, 0, At, B0); PG8_MMA(1, 1, At, B1); PG8_BAR; PG8_SCHED;
        }
        if (wr == 0) PG8_BAR;
        E(acc, cur, wr, wc, fr, fq);
        if (!has_next) break;
#pragma unroll
        for (int a = 0; a < 2; ++a)
#pragma unroll
            for (int b = 0; b < 2; ++b)
#pragma unroll
                for (int m = 0; m < 4; ++m)
#pragma unroll
                    for (int n = 0; n < 2; ++n) acc[a][b][m][n] = (f32x4){0.f, 0.f, 0.f, 0.f};
        cur = nxt; cA = nA; cB = nB; ++ui;
        if (wr == 1) PG8_BAR;
    }
    PG8_WAIT_V(0);
    PG8_BAR;
#undef PG8_SA
#undef PG8_SB
#undef PG8_STAGE
#undef PG8_LDA
#undef PG8_LDB
#undef PG8_MMA
#undef PG8_WAIT_V
#undef PG8_WAIT_L
#undef PG8_BAR
#undef PG8_SCHED
}
}

__host__ __device__ __forceinline__ int perm32inv(int c) { return 16 * ((c >> 2) & 1) + 4 * (c >> 3) + (c & 3); }
__host__ __device__ __forceinline__ int phys_row(int c, int mode) {
    if (mode == 0) return (c & ~31) + perm32inv(c & 31);
    const int tile = c >> 8, w = c & 255, wc = w >> 6, bj = (w >> 5) & 1;
    return tile * 256 + 128 * bj + 32 * wc + perm32inv(w & 31);
}

#define XB_TMO      128
#define XB_XCNT(j)  (256  + 64 * (j))
#define XB_XSUB(j)  (1280 + 64 * (j))
#define XB_XGEN(j)  (2304 + 64 * (j))
#define XB_TOP      3328
#define XB_TOPGEN   3392
#define XCD_BAR_WORDS 3456
#define XB_SPIN_CAP (1u << 20)
__device__ __forceinline__ unsigned xb_ld(unsigned* p)              { return __hip_atomic_load(p, __ATOMIC_RELAXED, __HIP_MEMORY_SCOPE_AGENT); }
__device__ __forceinline__ unsigned xb_add(unsigned* p, unsigned v) { return __hip_atomic_fetch_add(p, v, __ATOMIC_RELAXED, __HIP_MEMORY_SCOPE_AGENT); }
__device__ __forceinline__ unsigned xb_xcc_id() { return (unsigned)__builtin_amdgcn_s_getreg((3 << 11) | 20) & 0xFu; }
#define XB_SPIN(cond, bar) do { unsigned _sp = 0; while (cond) { __builtin_amdgcn_s_sleep(1); \
    if ((++_sp & 255u) == 0u) { if (xb_ld(&(bar)[XB_TMO])) break; if (_sp > XB_SPIN_CAP) { atomicAdd(&(bar)[XB_TMO], 1u); break; } } } } while (0)
struct XcdBarrier { unsigned* bar; unsigned x; volatile LAS unsigned* st; };
__device__ __forceinline__ XcdBarrier xcd_barrier_post(unsigned* bar, volatile LAS unsigned* st) {
    XcdBarrier b; b.bar = bar; b.x = xb_xcc_id(); b.st = st;
    if (threadIdx.x == 0) (void)xb_add(&bar[XB_XCNT(b.x)], 1u);
    return b;
}
__device__ __forceinline__ void xcd_barrier_complete(unsigned* bar, unsigned x, unsigned& nloc, unsigned& nx) {
    const unsigned G = gridDim.x * gridDim.y * gridDim.z;
    unsigned sum, cnt, mine, sp = 0u;
    for (;;) {
        sum = 0u; cnt = 0u; mine = 0u;
#pragma unroll
        for (unsigned j = 0; j < 16; ++j) { const unsigned c = xb_ld(&bar[XB_XCNT(j)]); sum += c; cnt += (c > 0u) ? 1u : 0u; mine = (j == x) ? c : mine; }
        if (sum == G) break;
        __builtin_amdgcn_s_sleep(1);
        if ((++sp & 255u) == 0u) { if (xb_ld(&bar[XB_TMO])) break; if (sp > XB_SPIN_CAP) { atomicAdd(&bar[XB_TMO], 1u); break; } }
    }
    nloc = mine > 0u ? mine : 1u; nx = cnt > 0u ? cnt : 1u;
}
__device__ __forceinline__ void xcd_barrier(const XcdBarrier& b) {
    asm volatile("s_waitcnt vmcnt(0)" ::: "memory");
    __syncthreads();
    if (threadIdx.x == 0) {
        unsigned* bar = b.bar;
        __builtin_amdgcn_s_waitcnt(0);
        unsigned nloc = b.st[0], nx = b.st[1];
        if (nloc == 0u) { xcd_barrier_complete(bar, b.x, nloc, nx); b.st[0] = nloc; b.st[1] = nx; }
        const unsigned old = xb_add(&bar[XB_XSUB(b.x)], 1u);
        const unsigned gen = old / nloc;
        if (old + 1u == (gen + 1u) * nloc) {
            __builtin_amdgcn_fence(__ATOMIC_RELEASE, "agent");
            asm volatile("s_waitcnt vmcnt(0)" ::: "memory");
            const unsigned og = xb_add(&bar[XB_TOP], 1u);
            const unsigned tg = og / nx;
            if (og + 1u == (tg + 1u) * nx) xb_add(&bar[XB_TOPGEN], 1u);
            else XB_SPIN(xb_ld(&bar[XB_TOPGEN]) == tg, bar);
            __builtin_amdgcn_fence(__ATOMIC_ACQUIRE, "agent");
            xb_add(&bar[XB_XGEN(b.x)], 1u);
            asm volatile("s_waitcnt vmcnt(0)" ::: "memory");
        } else {
            XB_SPIN(xb_ld(&bar[XB_XGEN(b.x)]) == gen, bar);
            __builtin_amdgcn_fence(__ATOMIC_ACQUIRE, "agent");
            asm volatile("s_waitcnt vmcnt(0)" ::: "memory");
        }
    }
    __syncthreads();
}

constexpr int RING_BYTES = 131072;
constexpr int LDSCTL_OFF = RING_BYTES, MISC_OFF = LDSCTL_OFF + 320;
constexpr int LDS_BYTES = 147456;

struct Args { const float* in[21]; float* out; unsigned char* ws; int ph_lo, ph_hi; };
struct Frame {
    LAS unsigned char* lds;
    int tid, lane, wave, G, bid;
    const float* const* in; float* out; unsigned char* ws; float* ctlf;
};
#define WSP(T, off) ((T*)(F.ws + (off)))
__device__ __forceinline__ const float* xrow_ptr(const Frame& F, int row) { return row < MP ? F.in[0] + (size_t)row * DM : F.in[1] + (size_t)(row - MP) * DM; }

__device__ __forceinline__ void p0_transpose_item(const float* W, int K, int N, const float* scale, bf16* WT, int row_off, int mode, LAS float* scr, int item, int lane) {
    const int nblk = N / 32, kb = item / nblk, nb = item % nblk, k0 = 64 * kb, n0 = 32 * nb;
#pragma unroll 8
    for (int i = 0; i < 32; ++i) { const int kk = 2 * i + (lane >> 5); const float s = scale ? scale[k0 + kk] : 1.f; scr[kk * 33 + (lane & 31)] = W[(size_t)(k0 + kk) * N + n0 + (lane & 31)] * s; }
    LDS_WAIT(); asm volatile("" ::: "memory");
    const int c = lane & 7;
#pragma unroll
    for (int j = 0; j < 4; ++j) { const int n = (lane >> 3) + 8 * j; const LAS float* s = scr + (8 * c) * 33 + n;
        v4u o; o.x = pk2(s[0 * 33], s[1 * 33]); o.y = pk2(s[2 * 33], s[3 * 33]); o.z = pk2(s[4 * 33], s[5 * 33]); o.w = pk2(s[6 * 33], s[7 * 33]);
        *(GAS v4u*)(WT + (size_t)(row_off + phys_row(n0 + n, mode)) * K + k0 + 8 * c) = o; }
    LDS_WAIT(); asm volatile("" ::: "memory");
}
__device__ __forceinline__ void p0_prologue(Frame& F) {
    LAS float* scr = (LAS float*)(F.lds + F.wave * 16384);
    const int gw = F.bid * 8 + F.wave, NGW = F.G * 8;
    const float* nmix = F.in[17]; const float* nffn = F.in[18];
    constexpr int I_SQ = 16 * 32, I_UP = 16 * 128, I_DN = 64 * 32, I_QKV = 16 * 288;
    constexpr int NITEMS = 4 * I_SQ + I_SQ + I_UP + I_DN + I_QKV + I_SQ + I_UP + I_DN;
    for (int it = gw; it < NITEMS; it += NGW) {
        int r = it;
        if (r < 4 * I_SQ) { const int w = r / I_SQ; p0_transpose_item(F.in[7 + w], DM, DM, nmix, WSP(bf16, WS_W1), w * DM, 0, scr, r % I_SQ, F.lane); continue; } r -= 4 * I_SQ;
        if (r < I_SQ) { p0_transpose_item(F.in[11], DM, DM, F.in[12], WSP(bf16, WS_WOH), 0, 0, scr, r, F.lane); continue; } r -= I_SQ;
        if (r < I_UP) { p0_transpose_item(F.in[19], DM, FF, nffn, WSP(bf16, WS_WUP0), 0, 0, scr, r, F.lane); continue; } r -= I_UP;
        if (r < I_DN) { p0_transpose_item(F.in[20], FF, DM, nullptr, WSP(bf16, WS_WDN0), 0, 0, scr, r, F.lane); continue; } r -= I_DN;
        if (r < I_QKV) { p0_transpose_item(F.in[13], DM, NQKV, nmix + DM, WSP(bf16, WS_WQKV), 0, 1, scr, r, F.lane); continue; } r -= I_QKV;
        if (r < I_SQ) { p0_transpose_item(F.in[14], DM, DM, nullptr, WSP(bf16, WS_WOA), 0, 0, scr, r, F.lane); continue; } r -= I_SQ;
        if (r < I_UP) { p0_transpose_item(F.in[19] + (size_t)DM * FF, DM, FF, nffn + DM, WSP(bf16, WS_WUP1), 0, 0, scr, r, F.lane); continue; } r -= I_UP;
        p0_transpose_item(F.in[20] + (size_t)FF * DM, FF, DM, nullptr, WSP(bf16, WS_WDN1), 0, 0, scr, r, F.lane);
    }
    bf16* XN = WSP(bf16, WS_XN); float* rs0 = F.ctlf + CW_RS;
    for (int m = gw; m < MT; m += NGW) {
        const GAS f32x4* xr = (const GAS f32x4*)xrow_ptr(F, m) + F.lane;
        f32x4 v[4]; float s = 0.f;
#pragma unroll
        for (int j = 0; j < 4; ++j) { v[j] = xr[64 * j]; s += (v[j].x * v[j].x + v[j].y * v[j].y) + (v[j].z * v[j].z + v[j].w * v[j].w); }
        s = wave_sum(s);
        GAS v2u* o8 = (GAS v2u*)(XN + (size_t)m * DM) + F.lane;
#pragma unroll
        for (int j = 0; j < 4; ++j) o8[64 * j] = (v2u){pk2(v[j].x, v[j].y), pk2(v[j].z, v[j].w)};
        if (F.lane == 0) rs0[m] = s;
    }
    { const int gt = F.bid * 512 + F.tid; if (gt < 1024) { const float* lg = F.in[6]; const float a = lg[gt], b = lg[1024 + gt], c = lg[2048 + gt]; const float mx = fmaxf(a, fmaxf(b, c));
        const float ea = expf(a - mx), eb = expf(b - mx), ec = expf(c - mx); F.ctlf[CW_LB + gt] = ea / (ea + eb + ec); } }
}

__device__ __forceinline__ float rstd_of(const float* rs, int row) { return rsqrtf(rs[row] * (1.f / DM) + EPS); }
__device__ __forceinline__ void st_bf8(bf16* p, const f32x4 a, const f32x4 b) { *(GAS v4u*)p = (v4u){pk2(a.x, a.y), pk2(a.z, a.w), pk2(b.x, b.y), pk2(b.z, b.w)}; }
__device__ __forceinline__ float sq4(const f32x4 a) { return (a.x * a.x + a.y * a.y) + (a.z * a.z + a.w * a.w); }
__device__ __forceinline__ void row_atomic(float* rs, int row, float s, int fq) { s += __shfl_xor(s, 16); s += __shfl_xor(s, 32); if (fq == 0) atomicAdd(rs + row, s); }

struct RowE1 {
    const float* rs; const float* lb; bf16* QH; float* LOGF; bf16* VH; bf16* GH;
    __device__ __forceinline__ void row(int row, int pn, int wc, int fq, f32x4 a00, f32x4 a01, f32x4 a10, f32x4 a11) const {
        const float r = rstd_of(rs, row); const int blk = pn >> 2;
#pragma unroll
        for (int bj = 0; bj < 2; ++bj) {
            f32x4 u = (bj ? a10 : a00) * r, v = (bj ? a11 : a01) * r;
            const int cc = ((pn & 3) << 8) + 128 * bj + 32 * wc + 8 * fq; const size_t off = (size_t)row * DM + cc;
            if (blk == 0) {
#pragma unroll
                for (int j = 0; j < 4; ++j) { u[j] = silu_f(u[j]); v[j] = silu_f(v[j]); }
                st_bf8(QH + off, u, v);
            } else if (blk == 1) {
                const f32x4 l0 = *(const f32x4*)(lb + cc), l1 = *(const f32x4*)(lb + cc + 4);
#pragma unroll
                for (int j = 0; j < 4; ++j) { const float s0 = 1.f / (1.f + fast_exp(-u[j])), s1 = 1.f / (1.f + fast_exp(-v[j])); u[j] = __logf(l0[j] + (1.f - l0[j]) * s0); v[j] = __logf(l1[j] + (1.f - l1[j]) * s1); }
                *(GAS f32x4*)(LOGF + off) = u; *(GAS f32x4*)(LOGF + off + 4) = v;
            } else if (blk == 2) {
                st_bf8(VH + off, u, v);
            } else {
#pragma unroll
                for (int j = 0; j < 4; ++j) { u[j] = silu_f(u[j]); v[j] = silu_f(v[j]); }
                st_bf8(GH + off, u, v);
            }
        }
    }
};
__device__ __forceinline__ void nt_store4(float* p, f32x4 v) { __builtin_nontemporal_store(v, (f32x4*)p); }
struct RowERes {
    const float* rs_in;
    const float* xp; const float* xs;
    float* Yout; bf16* XN; bool wr_xn; float* rs_out;
    __device__ __forceinline__ void row(int row, int pn, int wc, int fq, f32x4 a00, f32x4 a01, f32x4 a10, f32x4 a11) const {
        const float r = rs_in ? rstd_of(rs_in, row) : 1.f;
        float ss = 0.f;
#pragma unroll
        for (int bj = 0; bj < 2; ++bj) {
            const int cc = (pn << 8) + 128 * bj + 32 * wc + 8 * fq; const size_t off = (size_t)row * DM + cc;
            f32x4 b0, b1;
            if (xp) { const float* base = (row < MP ? xp + (size_t)row * DM : xs + (size_t)(row - MP) * DM) + cc; b0 = *(const GAS f32x4*)(base); b1 = *(const GAS f32x4*)(base + 4); }
            else { const v4u w = *(const GAS v4u*)(XN + off); b0 = (f32x4){bflo(w.x), bfhi(w.x), bflo(w.y), bfhi(w.y)}; b1 = (f32x4){bflo(w.z), bfhi(w.z), bflo(w.w), bfhi(w.w)}; }
            const f32x4 u = b0 + (bj ? a10 : a00) * r, v = b1 + (bj ? a11 : a01) * r;
            if (Yout) { nt_store4(Yout + off, u); nt_store4(Yout + off + 4, v); }
            if (wr_xn) st_bf8(XN + off, u, v);
            ss += sq4(u) + sq4(v);
        }
        if (rs_out) row_atomic(rs_out, row, ss, fq);
    }
};
struct RowEUp {
    const float* rs; bf16* H;
    __device__ __forceinline__ void row(int row, int pn, int wc, int fq, f32x4 a00, f32x4 a01, f32x4 a10, f32x4 a11) const {
        const float r = rstd_of(rs, row);
#pragma unroll
        for (int bj = 0; bj < 2; ++bj) {
            f32x4 u = (bj ? a10 : a00) * r, v = (bj ? a11 : a01) * r;
#pragma unroll
            for (int j = 0; j < 4; ++j) { const float p = fmaxf(u[j], 0.f), q = fmaxf(v[j], 0.f); u[j] = p * p; v[j] = q * q; }
            st_bf8(H + (size_t)row * FF + (pn << 8) + 128 * bj + 32 * wc + 8 * fq, u, v);
        }
    }
};
struct RowEQkv {
    const float* rs; const float* qn; const float* kn; unsigned char* qkv_base; float* out;
    __device__ __forceinline__ void row(int row, int pn, int wc, int fq, f32x4 a00, f32x4 a01, f32x4 a10, f32x4 a11) const {
        const float r = rstd_of(rs, row);
        const int which = pn / 12, g = (pn >> 2) % 3, h = 4 * (pn & 3) + wc;
        f32x4 v[2][2] = {{a00 * r, a01 * r}, {a10 * r, a11 * r}};
        if (which < 2) {
            float ss = sq4(v[0][0]) + sq4(v[0][1]) + sq4(v[1][0]) + sq4(v[1][1]);
            ss += __shfl_xor(ss, 16); ss += __shfl_xor(ss, 32);
            float sc = rsqrtf(ss * (1.f / 64.f) + EPS); if (which == 0) sc *= QSCALE;
            const float* wn = which == 0 ? qn : kn;
#pragma unroll
            for (int bj = 0; bj < 2; ++bj)
#pragma unroll
                for (int n = 0; n < 2; ++n) { const f32x4 w = *(const f32x4*)(wn + 32 * bj + 8 * fq + 4 * n); v[bj][n] = v[bj][n] * w * sc; }
        }
        int arow = row, b, t = 0; const bool prompt = row < MP;
        const int dsh = 2 * g;
        if (prompt) { b = row >> 12; t = row & 4095; arow = (b << 12) + ((t & ((1 << dsh) - 1)) << (12 - dsh)) + (t >> dsh); } else { b = (row - MP) >> 3; }
        bf16* dst = (bf16*)(qkv_base + (size_t)(which * 3 + g) * QKV_STRIDE) + (size_t)arow * DM + h * 64 + 8 * fq;
        st_bf8(dst, v[0][0], v[0][1]); st_bf8(dst + 32, v[1][0], v[1][1]);
        if (which >= 1) {
            const int W = 128 << (2 * g);
            float* o = nullptr;
            if (prompt) { if (t >= SEQ - W) o = out + (g == 0 ? O_KV128P : g == 1 ? O_KV512P : O_KV2048P) + ((size_t)(b * W + (t - (SEQ - W))) * 2 + (which - 1)) * 1024; }
            else o = out + (g == 0 ? O_KV128S : g == 1 ? O_KV512S : O_KV2048S) + ((size_t)(row - MP) * 2 + (which - 1)) * 1024;
            if (o) { o += h * 64 + 8 * fq;
                nt_store4(o, v[0][0]); nt_store4(o + 4, v[0][1]); nt_store4(o + 32, v[1][0]); nt_store4(o + 36, v[1][1]); }
        }
    }
};
template <class RowEpi> struct EpiWrap {
    RowEpi R;
    __device__ __forceinline__ void operator()(const f32x4 (&acc)[2][2][4][2], const pg8::Unit& u, int wr, int wc, int fr, int fq) const {
#pragma unroll
        for (int ai = 0; ai < 2; ++ai)
#pragma unroll
            for (int m = 0; m < 4; ++m) R.row(u.pm * 256 + ai * 128 + wr * 64 + m * 16 + fr, u.pn, wc, fq, acc[ai][0][m][0], acc[ai][0][m][1], acc[ai][1][m][0], acc[ai][1][m][1]);
    }
};

template <class RowEpi>
__device__ __forceinline__ void small_gemm(Frame& F, const bf16* A  , const bf16* Bt, int N, int K, const RowEpi& R) {
    const int lane = F.lane, fr = lane & 15, fq = lane >> 4, w = F.wave;
    const int nunits = 8 * (N / 64), kw = K / 8;
    LAS f32x4* part = (LAS f32x4*)F.lds;
    for (int u = F.bid; u < nunits; u += F.G) {
        const int rb = u & 7, cg = u >> 3, pn = cg >> 2, wc = cg & 3;
        f32x4 acc[2][2][2];
#pragma unroll
        for (int m = 0; m < 2; ++m)
#pragma unroll
            for (int bj = 0; bj < 2; ++bj)
#pragma unroll
                for (int n = 0; n < 2; ++n) acc[m][bj][n] = (f32x4){0.f, 0.f, 0.f, 0.f};
        const bf16* ap = A + (size_t)(rb * 32 + fr) * K + w * kw + 8 * fq;
        const bf16* bp = Bt + (size_t)(pn * 256 + 32 * wc + fr) * K + w * kw + 8 * fq;
#pragma unroll 4
        for (int k = 0; k < kw; k += 32) {
            bf16x8 a[2], b[2][2];
#pragma unroll
            for (int m = 0; m < 2; ++m) a[m] = *(const GAS bf16x8*)(ap + (size_t)(16 * m) * K + k);
#pragma unroll
            for (int bj = 0; bj < 2; ++bj)
#pragma unroll
                for (int n = 0; n < 2; ++n) b[bj][n] = *(const GAS bf16x8*)(bp + (size_t)(128 * bj + 16 * n) * K + k);
#pragma unroll
            for (int m = 0; m < 2; ++m)
#pragma unroll
                for (int bj = 0; bj < 2; ++bj)
#pragma unroll
                    for (int n = 0; n < 2; ++n) acc[m][bj][n] = __builtin_amdgcn_mfma_f32_16x16x32_bf16(b[bj][n], a[m], acc[m][bj][n], 0, 0, 0);
        }
#pragma unroll
        for (int m = 0; m < 2; ++m)
#pragma unroll
            for (int bj = 0; bj < 2; ++bj)
#pragma unroll
                for (int n = 0; n < 2; ++n) part[(w * 8 + m * 4 + bj * 2 + n) * 64 + lane] = acc[m][bj][n];
        __syncthreads();
        if (w < 2) {
            f32x4 s[2][2];
#pragma unroll
            for (int bj = 0; bj < 2; ++bj)
#pragma unroll
                for (int n = 0; n < 2; ++n) { f32x4 t = (f32x4){0.f, 0.f, 0.f, 0.f};
#pragma unroll
                    for (int ww = 0; ww < 8; ++ww) t += part[(ww * 8 + w * 4 + bj * 2 + n) * 64 + lane];
                    s[bj][n] = t; }
            R.row(MP + rb * 32 + 16 * w + fr, pn, wc, fq, s[0][0], s[0][1], s[1][0], s[1][1]);
        }
        __syncthreads();
    }
}

__device__ __forceinline__ bf16x8 ldfrag(const LAS unsigned char* base, int row, int pitch, int ks, int g) { return *(const LAS bf16x8*)(base + row * pitch + ks * 64 + g * 16); }
#define MFMA16(a, b, c) __builtin_amdgcn_mfma_f32_16x16x32_bf16((a), (b), (c), 0, 0, 0)

constexpr int H_QP = 0, H_KP = 17408, H_KT = 34816, H_VT = 53248, H_PM = 71680, H_ST = 80896, H_TOT = 115712, H_DV = 117760;
constexpr int P272 = 272, P144 = 144;
__device__ __forceinline__ void hgrn_b1(Frame& F) {
    const bf16* QH = WSP(bf16, WS_QH); const bf16* VH = WSP(bf16, WS_VH); const float* LOGF = WSP(float, WS_LOGF);
    bf16* Q2 = WSP(bf16, WS_Q2); bf16* OL = WSP(bf16, WS_OL); float* SL = WSP(float, WS_SL); float* DT = WSP(float, WS_DT);
    LAS unsigned char* L = F.lds;
    const int tid = F.tid, lane = F.lane, w = F.wave, r = lane & 15, g = lane >> 4;
    const int col = tid & 127, qr = tid >> 7;
    LAS float* TOT = (LAS float*)(L + H_TOT); LAS float* DV = (LAS float*)(L + H_DV);
    for (int it = F.bid; it < 512; it += F.G) {
        const int bh = it >> 4, j = it & 15, b = bh >> 3, h = bh & 7;
        const size_t grow0 = (size_t)b * SEQ + j * 256;
        float base = 0.f;
        f32x4 accS[8];
#pragma unroll
        for (int i = 0; i < 8; ++i) accS[i] = (f32x4){0.f, 0.f, 0.f, 0.f};
        for (int c = 0; c < 4; ++c) {
            const size_t e0 = (grow0 + c * 64 + qr * 16) * DM + h * 128 + col;
            float lf[16]; unsigned short qv[16], vv[16];
#pragma unroll
            for (int i = 0; i < 16; ++i) { lf[i] = LOGF[e0 + (size_t)i * DM]; qv[i] = QH[e0 + (size_t)i * DM]; vv[i] = VH[e0 + (size_t)i * DM]; }
            float cum[16]; float run = 0.f;
#pragma unroll
            for (int i = 0; i < 16; ++i) { run += lf[i]; cum[i] = run; }
            TOT[qr * 128 + col] = run;
            __syncthreads();
            float offs = 0.f, last = 0.f;
#pragma unroll
            for (int q = 0; q < 4; ++q) { const float tq = TOT[q * 128 + col]; if (q < qr) offs += tq; last += tq; }
            unsigned ktw[8], vtw[8];
#pragma unroll
            for (int i = 0; i < 16; ++i) {
                const float cv = cum[i] + offs, q = bf2f(qv[i]);
                const float kk = 1.f - fast_exp(lf[i]);
                const float qp = q * fast_exp(cv), kp = kk * fast_exp(-cv), k2 = kk * fast_exp(last - cv), q2 = q * fast_exp(cv + base);
                const int t = qr * 16 + i;
                *(LAS unsigned short*)(L + H_QP + t * P272 + col * 2) = (unsigned short)pk2(qp, 0.f);
                *(LAS unsigned short*)(L + H_KP + t * P272 + col * 2) = (unsigned short)pk2(kp, 0.f);
                Q2[e0 + (size_t)i * DM] = (unsigned short)pk2(q2, 0.f);
                const unsigned kb = pk2(k2, 0.f) & 0xffffu;
                if (i & 1) { ktw[i >> 1] |= kb << 16; vtw[i >> 1] |= (unsigned)vv[i] << 16; } else { ktw[i >> 1] = kb; vtw[i >> 1] = vv[i]; }
            }
            *(LAS v4u*)(L + H_KT + col * P144 + qr * 32) = (v4u){ktw[0], ktw[1], ktw[2], ktw[3]};
            *(LAS v4u*)(L + H_KT + col * P144 + qr * 32 + 16) = (v4u){ktw[4], ktw[5], ktw[6], ktw[7]};
            *(LAS v4u*)(L + H_VT + col * P144 + qr * 32) = (v4u){vtw[0], vtw[1], vtw[2], vtw[3]};
            *(LAS v4u*)(L + H_VT + col * P144 + qr * 32 + 16) = (v4u){vtw[4], vtw[5], vtw[6], vtw[7]};
            if (qr == 0) DV[col] = fast_exp(last);
            base += last;
            __syncthreads();
            {
                const int tm = w & 3;
#pragma unroll
                for (int i = 0; i < 2; ++i) {
                    const int tn = 2 * (w >> 2) + i;
                    f32x4 a = (f32x4){0.f, 0.f, 0.f, 0.f};
                    if (tn <= tm) {
#pragma unroll
                        for (int ks = 0; ks < 4; ++ks) a = MFMA16(ldfrag(L + H_KP, 16 * tn + r, P272, ks, g), ldfrag(L + H_QP, 16 * tm + r, P272, ks, g), a);
                        if (tn == tm) {
#pragma unroll
                            for (int e = 0; e < 4; ++e) if (4 * g + e > r) a[e] = 0.f;
                        }
                    }
                    *(LAS v2u*)(L + H_PM + (16 * tm + r) * P144 + (16 * tn + 4 * g) * 2) = (v2u){pk2(a[0], a[1]), pk2(a[2], a[3])};
                }
            }
            __syncthreads();
            {
                const int tm = w & 3;
#pragma unroll
                for (int i = 0; i < 4; ++i) {
                    const int tn = 4 * (w >> 2) + i;
                    f32x4 a = (f32x4){0.f, 0.f, 0.f, 0.f};
#pragma unroll
                    for (int ks = 0; ks < 2; ++ks) a = MFMA16(ldfrag(L + H_VT, 16 * tn + r, P144, ks, g), ldfrag(L + H_PM, 16 * tm + r, P144, ks, g), a);
                    if (c > 0) {
#pragma unroll
                        for (int ks = 0; ks < 4; ++ks) a = MFMA16(ldfrag(L + H_ST, 16 * tn + r, P272, ks, g), ldfrag(L + H_QP, 16 * tm + r, P272, ks, g), a);
                    }
                    *(GAS v2u*)(OL + (grow0 + c * 64 + 16 * tm + r) * DM + h * 128 + 16 * tn + 4 * g) = (v2u){pk2(a[0], a[1]), pk2(a[2], a[3])};
                }
            }
            __syncthreads();
#pragma unroll
            for (int tk = 0; tk < 8; ++tk) {
                const f32x4 d = *(const LAS f32x4*)(DV + 16 * tk + 4 * g);
                f32x4 a = accS[tk] * d;
#pragma unroll
                for (int ks = 0; ks < 2; ++ks) a = MFMA16(ldfrag(L + H_KT, 16 * tk + r, P144, ks, g), ldfrag(L + H_VT, 16 * w + r, P144, ks, g), a);
                accS[tk] = a;
                *(LAS v2u*)(L + H_ST + (16 * w + r) * P272 + (16 * tk + 4 * g) * 2) = (v2u){pk2(a[0], a[1]), pk2(a[2], a[3])};
            }
            __syncthreads();
        }
#pragma unroll
        for (int tk = 0; tk < 8; ++tk) *(GAS f32x4*)(SL + (size_t)it * 16384 + (16 * w + r) * 128 + 16 * tk + 4 * g) = accS[tk];
        if (qr == 0) DT[it * 128 + col] = fast_exp(base);
    }
}
__device__ __forceinline__ void hgrn_sample(Frame& F, float* rso) {
    const bf16* QH = WSP(bf16, WS_QH); const bf16* VH = WSP(bf16, WS_VH); const bf16* GH = WSP(bf16, WS_GH); const float* LOGF = WSP(float, WS_LOGF);
    bf16* A3 = WSP(bf16, WS_A3);
    const float* S0 = F.in[2]; float* SO = F.out + O_SHS;
    LAS float* qs = (LAS float*)F.lds; LAS float* fs = qs + 1024; LAS float* vs = fs + 1024; LAS float* gs = vs + 1024; LAS float* red = gs + 1024;
    const int tid = F.tid, v = tid & 127, kq = tid >> 7;
    for (int it = F.bid; it < 256; it += F.G) {
        const int b = it >> 3, h = it & 7;
        __syncthreads();
        for (int e = tid; e < 1024; e += 512) { const int t = e >> 7, c = e & 127; const size_t off = (size_t)(MP + b * 8 + t) * DM + h * 128 + c;
            qs[e] = bf2f(QH[off]); fs[e] = fast_exp(LOGF[off]); vs[e] = bf2f(VH[off]); gs[e] = bf2f(GH[off]); }
        float S[32];
        const size_t sb = ((size_t)it * 128 + 32 * kq) * 128 + v;
#pragma unroll
        for (int i = 0; i < 32; ++i) S[i] = S0[sb + (size_t)i * 128];
        __syncthreads();
#pragma unroll 1
        for (int t = 0; t < 8; ++t) {
            const float vt = vs[t * 128 + v]; float po = 0.f;
#pragma unroll
            for (int i = 0; i < 32; ++i) { const float fk = fs[t * 128 + 32 * kq + i]; S[i] = fk * S[i] + (1.f - fk) * vt; po += qs[t * 128 + 32 * kq + i] * S[i]; }
            red[(t * 4 + kq) * 128 + v] = po;
        }
#pragma unroll
        for (int i = 0; i < 32; ++i) SO[sb + (size_t)i * 128] = S[i];
        __syncthreads();
        { const int t = F.wave; float ss = 0.f; const int row = MP + b * 8 + t;
#pragma unroll
            for (int hh = 0; hh < 2; ++hh) { const int vv = F.lane + 64 * hh; const float o = (red[(t * 4 + 0) * 128 + vv] + red[(t * 4 + 1) * 128 + vv]) + (red[(t * 4 + 2) * 128 + vv] + red[(t * 4 + 3) * 128 + vv]);
                ss += o * o; A3[(size_t)row * DM + h * 128 + vv] = (unsigned short)pk2(o * gs[t * 128 + vv], 0.f); }
            ss = wave_sum(ss); if (F.lane == 0) atomicAdd(rso + row, ss); }
    }
    __syncthreads();
}
__device__ __forceinline__ void hgrn_scan(Frame& F) {
    const float* SL = WSP(float, WS_SL); const float* DT = WSP(float, WS_DT); bf16* SS = WSP(bf16, WS_SS); float* SHP = F.out + O_SHP;
    for (int idx = F.bid * 512 + F.tid; idx < 32 * 128 * 32; idx += F.G * 512) {
        const int bh = idx >> 12, v = (idx >> 5) & 127, k = (idx & 31) * 4;
        f32x4 s = (f32x4){0.f, 0.f, 0.f, 0.f};
#pragma unroll 4
        for (int j = 0; j < 16; ++j) { const int it = bh * 16 + j;
            *(GAS v2u*)(SS + (size_t)it * 16384 + v * 128 + k) = (v2u){pk2(s.x, s.y), pk2(s.z, s.w)};
            const f32x4 d = *(const GAS f32x4*)(DT + it * 128 + k), sl = *(const GAS f32x4*)(SL + (size_t)it * 16384 + v * 128 + k);
            s = d * s + sl; }
#pragma unroll
        for (int e = 0; e < 4; ++e) SHP[(size_t)bh * 16384 + (k + e) * 128 + v] = s[e];
    }
}
constexpr int B3_Q = 0, B3_S = 69632;
__device__ __forceinline__ void hgrn_b3(Frame& F, float* rso) {
    const bf16* Q2 = WSP(bf16, WS_Q2); const bf16* OL = WSP(bf16, WS_OL); const bf16* GH = WSP(bf16, WS_GH); const bf16* SS = WSP(bf16, WS_SS);
    bf16* A3 = WSP(bf16, WS_A3);
    LAS unsigned char* L = F.lds; const int tid = F.tid, lane = F.lane, w = F.wave, r = lane & 15, g = lane >> 4;
    for (int it = F.bid; it < 512; it += F.G) {
        const int bh = it >> 4, j = it & 15, b = bh >> 3, h = bh & 7; const size_t grow0 = (size_t)b * SEQ + j * 256;
        __syncthreads();
#pragma unroll
        for (int i = 0; i < 8; ++i) { const int ch = tid + 512 * i, row = ch >> 4, c16 = ch & 15; *(LAS v4u*)(L + B3_Q + row * P272 + c16 * 16) = *(const GAS v4u*)(Q2 + (grow0 + row) * DM + h * 128 + c16 * 8); }
#pragma unroll
        for (int i = 0; i < 4; ++i) { const int ch = tid + 512 * i, row = ch >> 4, c16 = ch & 15; *(LAS v4u*)(L + B3_S + row * P272 + c16 * 16) = *(const GAS v4u*)(SS + (size_t)it * 16384 + row * 128 + c16 * 8); }
        __syncthreads();
#pragma unroll
        for (int mi = 0; mi < 2; ++mi) {
            const int t = 32 * w + 16 * mi + r; const size_t rowoff = (grow0 + t) * DM + h * 128;
            bf16x8 qa[4];
#pragma unroll
            for (int ks = 0; ks < 4; ++ks) qa[ks] = ldfrag(L + B3_Q, t, P272, ks, g);
            float ss = 0.f;
#pragma unroll
            for (int tn = 0; tn < 8; ++tn) {
                f32x4 a = (f32x4){0.f, 0.f, 0.f, 0.f};
#pragma unroll
                for (int ks = 0; ks < 4; ++ks) a = MFMA16(ldfrag(L + B3_S, 16 * tn + r, P272, ks, g), qa[ks], a);
                const v2u ol = *(const GAS v2u*)(OL + rowoff + 16 * tn + 4 * g), gg = *(const GAS v2u*)(GH + rowoff + 16 * tn + 4 * g);
                const float o0 = a[0] + bflo(ol.x), o1 = a[1] + bfhi(ol.x), o2 = a[2] + bflo(ol.y), o3 = a[3] + bfhi(ol.y);
                ss += (o0 * o0 + o1 * o1) + (o2 * o2 + o3 * o3);
                *(GAS v2u*)(A3 + rowoff + 16 * tn + 4 * g) = (v2u){pk2(o0 * bflo(gg.x), o1 * bfhi(gg.x)), pk2(o2 * bflo(gg.y), o3 * bfhi(gg.y))};
            }
            ss += __shfl_xor(ss, 16); ss += __shfl_xor(ss, 32);
            if (g == 0) atomicAdd(rso + grow0 + t, ss);
        }
    }
    __syncthreads();
}

constexpr int AT_K = 0, AT_V = 36864, AT_VROWS = 272;
__device__ __forceinline__ s16x4 tr16(const LAS unsigned char* p) { return __builtin_bit_cast(s16x4, __builtin_amdgcn_ds_read_tr16_b64_v4i16((LAS s16x4*)p)); }
__device__ __forceinline__ float alibi_slope2(int g, int h) { return exp2f(-8.f * (float)(g * 16 + h + 1) / 48.f) * LOG2E; }
__device__ __forceinline__ void att_decode(int it, int& grp, int& h, int& seq, int& q0) {
    grp = it >> 11; const int rem = it & 2047, dsh = 2 * grp, nsh = 5 - dsh;
    q0 = (rem & ((1 << nsh) - 1)) << 7; const int hs = rem >> nsh; h = hs & 15; seq = hs >> 4;
}
#define ATT_LOAD(itv) do { int grp_, h_, seq_, q0_; att_decode((itv), grp_, h_, seq_, q0_); const int Lq_ = 4096 >> (2 * grp_); const size_t sb_ = (size_t)seq_ * Lq_; \
        const bf16* Kg_ = (const bf16*)(F.ws + WS_QKV + (size_t)(3 + grp_) * QKV_STRIDE); const bf16* Vg_ = (const bf16*)(F.ws + WS_QKV + (size_t)(6 + grp_) * QKV_STRIDE); \
        const bf16* Qg_ = (const bf16*)(F.ws + WS_QKV + (size_t)grp_ * QKV_STRIDE); \
        _Pragma("unroll") for (int i = 0; i < 4; ++i) { const int ch = tid + 512 * i, row = ch >> 3, c8 = ch & 7; const int kp = q0_ - 128 + row; \
            kq[i] = (v4u){0u, 0u, 0u, 0u}; vq[i] = (v4u){0u, 0u, 0u, 0u}; \
            if (kp >= 0) { const size_t off = (sb_ + kp) * DM + h_ * 64 + c8 * 8; kq[i] = *(const GAS v4u*)(Kg_ + off); vq[i] = *(const GAS v4u*)(Vg_ + off); } } \
        _Pragma("unroll") for (int ks = 0; ks < 2; ++ks) qn[ks] = *(const GAS bf16x8*)(Qg_ + (sb_ + q0_ + 16 * w + r) * DM + h_ * 64 + 32 * ks + 8 * g4); } while (0)
__device__ __forceinline__ void attn_prompt(Frame& F) {
    LAS unsigned char* L = F.lds; const int tid = F.tid, lane = F.lane, w = F.wave, r = lane & 15, g4 = lane >> 4;
    float* LSE = WSP(float, WS_LSE);
    __syncthreads();
    for (int e = tid; e < 16 * P144 / 4; e += 512) *(LAS unsigned*)(L + AT_V + 256 * P144 + e * 4) = 0u;
    v4u kq[4], vq[4]; bf16x8 qn[2];
    int it = F.bid;
    if (it < 6144) ATT_LOAD(it);
    for (; it < 6144; it += F.G) {
        int grp, h, seq, q0; att_decode(it, grp, h, seq, q0);
        const int dsh = 2 * grp;
        bf16* Og = (bf16*)(F.ws + WS_OG + (size_t)grp * QKV_STRIDE);
        __syncthreads();
#pragma unroll
        for (int i = 0; i < 4; ++i) { const int ch = tid + 512 * i, row = ch >> 3, c8 = ch & 7; *(LAS v4u*)(L + AT_K + row * P144 + c8 * 16) = kq[i]; *(LAS v4u*)(L + AT_V + row * P144 + c8 * 16) = vq[i]; }
        bf16x8 qf[2]; qf[0] = qn[0]; qf[1] = qn[1];
        __syncthreads();
        if (it + F.G < 6144) ATT_LOAD(it + F.G);
        const int qw0 = q0 + 16 * w;
        const float sl2 = alibi_slope2(grp, h) * (float)(1 << dsh);
        f32x4 st[10];
#pragma unroll
        for (int T = 0; T < 9; ++T) {
            f32x4 a = (f32x4){0.f, 0.f, 0.f, 0.f};
#pragma unroll
            for (int ks = 0; ks < 2; ++ks) a = MFMA16(ldfrag(L + AT_K, 16 * w + 16 * T + r, P144, ks, g4), qf[ks], a);
            st[T] = a;
        }
        float mx = -INFINITY;
#pragma unroll
        for (int T = 0; T < 9; ++T)
#pragma unroll
            for (int e = 0; e < 4; ++e) { const int iw = 16 * T + 4 * g4 + e, dist = r + 128 - iw; const bool ok = dist >= 0 && dist <= 128 && (qw0 - 128 + iw) >= 0;
                const float x = ok ? st[T][e] - sl2 * (float)dist : -INFINITY; st[T][e] = x; mx = fmaxf(mx, x); }
        mx = fmaxf(mx, __shfl_xor(mx, 16)); mx = fmaxf(mx, __shfl_xor(mx, 32));
        float lsum = 0.f;
#pragma unroll
        for (int T = 0; T < 9; ++T)
#pragma unroll
            for (int e = 0; e < 4; ++e) { const float p = __builtin_amdgcn_exp2f(st[T][e] - mx); st[T][e] = p; lsum += p; }
        st[9] = (f32x4){0.f, 0.f, 0.f, 0.f};
        lsum += __shfl_xor(lsum, 16); lsum += __shfl_xor(lsum, 32);
        f32x4 oa[4];
#pragma unroll
        for (int dt = 0; dt < 4; ++dt) oa[dt] = (f32x4){0.f, 0.f, 0.f, 0.f};
#pragma unroll
        for (int u = 0; u < 5; ++u) {
            const v4u pw = (v4u){pk2(st[2 * u][0], st[2 * u][1]), pk2(st[2 * u][2], st[2 * u][3]), pk2(st[2 * u + 1][0], st[2 * u + 1][1]), pk2(st[2 * u + 1][2], st[2 * u + 1][3])};
            const bf16x8 pf = __builtin_bit_cast(bf16x8, pw);
#pragma unroll
            for (int dt = 0; dt < 4; ++dt) {
                const LAS unsigned char* vb = L + AT_V + (16 * w + 32 * u + 4 * g4 + (r >> 2)) * P144 + (16 * dt + 4 * (r & 3)) * 2;
                const s16x4 lo = tr16(vb), hi = tr16(vb + 16 * P144);
                const bf16x8 vf = (bf16x8){lo[0], lo[1], lo[2], lo[3], hi[0], hi[1], hi[2], hi[3]};
                oa[dt] = MFMA16(vf, pf, oa[dt]);
            }
        }
        const float inv = 1.f / lsum;
        const int m = qw0 + r, res = seq & ((1 << dsh) - 1), b = seq >> dsh;
        const size_t nrow = (size_t)b * SEQ + ((size_t)m << dsh) + res;
#pragma unroll
        for (int dt = 0; dt < 4; ++dt) *(GAS v2u*)(Og + nrow * DM + h * 64 + 16 * dt + 4 * g4) = (v2u){pk2(oa[dt][0] * inv, oa[dt][1] * inv), pk2(oa[dt][2] * inv, oa[dt][3] * inv)};
        if (g4 == 0) LSE[((size_t)grp * MT + nrow) * 16 + h] = (mx + __log2f(lsum)) * LN2;
    }
    __syncthreads();
}
__device__ __forceinline__ void attn_sample(Frame& F) {
    const int lane = F.lane, ksub = lane >> 4, dc = lane & 15, w = F.wave;
    float* LSE = WSP(float, WS_LSE);
    for (int it = F.bid; it < 768; it += F.G) {
        const int s = it & 7, grp = (it >> 3) % 3, b = it / 24;
        const int dsh = 2 * grp, W = 128 << dsh, dil = 1 << dsh;
        const float* cache = F.in[3 + grp] + (size_t)b * W * 2048;
        const float* newkv = F.out + (grp == 0 ? O_KV128S : grp == 1 ? O_KV512S : O_KV2048S) + (size_t)b * 8 * 2048;
        const bf16* Qg = (const bf16*)(F.ws + WS_QKV + (size_t)grp * QKV_STRIDE);
        bf16* Og = (bf16*)(F.ws + WS_OG + (size_t)grp * QKV_STRIDE);
        const size_t row = (size_t)MP + b * 8 + s;
#pragma unroll 1
        for (int hh = 0; hh < 2; ++hh) {
            const int h = 2 * w + hh;
            const v2u qw = *(const GAS v2u*)(Qg + row * DM + h * 64 + 4 * dc);
            const f32x4 q = (f32x4){bflo(qw.x), bfhi(qw.x), bflo(qw.y), bfhi(qw.y)};
            const float sl2 = alibi_slope2(grp, h) * (float)dil;
            float mx = -INFINITY, lsum = 0.f; f32x4 o = (f32x4){0.f, 0.f, 0.f, 0.f};
#pragma unroll 1
            for (int j0 = 0; j0 < 132; j0 += 32) {
                f32x4 kx[8], vx[8];
#pragma unroll
                for (int i = 0; i < 8; ++i) { int j = j0 + 4 * i + ksub; if (j > 128) j = 128; const int idx = W + s - dil * j;
                    const float* rp = idx >= W ? newkv + (size_t)(idx - W) * 2048 : cache + (size_t)idx * 2048;
                    kx[i] = *(const GAS f32x4*)(rp + h * 64 + 4 * dc); vx[i] = *(const GAS f32x4*)(rp + 1024 + h * 64 + 4 * dc); }
                float sc[8]; float bm = -INFINITY;
#pragma unroll
                for (int i = 0; i < 8; ++i) { const int j = j0 + 4 * i + ksub;
                    float d = (kx[i].x * q.x + kx[i].y * q.y) + (kx[i].z * q.z + kx[i].w * q.w);
                    d += __shfl_xor(d, 1); d += __shfl_xor(d, 2); d += __shfl_xor(d, 4); d += __shfl_xor(d, 8);
                    sc[i] = j <= 128 ? d - sl2 * (float)j : -INFINITY; bm = fmaxf(bm, sc[i]); }
                bm = fmaxf(bm, __shfl_xor(bm, 16)); bm = fmaxf(bm, __shfl_xor(bm, 32));
                const float nm = fmaxf(mx, bm), f = __builtin_amdgcn_exp2f(mx - nm);
                lsum *= f; o = o * f; mx = nm;
#pragma unroll
                for (int i = 0; i < 8; ++i) { const float p = __builtin_amdgcn_exp2f(sc[i] - mx); lsum += p; o += vx[i] * p; }
            }
            lsum += __shfl_xor(lsum, 16); lsum += __shfl_xor(lsum, 32);
#pragma unroll
            for (int e = 0; e < 4; ++e) { o[e] += __shfl_xor(o[e], 16); o[e] += __shfl_xor(o[e], 32); }
            const float inv = 1.f / lsum;
            if (ksub == 0) *(GAS v2u*)(Og + row * DM + h * 64 + 4 * dc) = (v2u){pk2(o[0] * inv, o[1] * inv), pk2(o[2] * inv, o[3] * inv)};
            if (lane == 0) LSE[((size_t)grp * MT + row) * 16 + h] = (mx + __log2f(lsum)) * LN2;
        }
    }
}
__device__ __forceinline__ void attn_merge(Frame& F) {
    const float* LSE = WSP(float, WS_LSE); bf16* OM = WSP(bf16, WS_OM);
    for (int idx = F.bid * 512 + F.tid; idx < MT * 128; idx += F.G * 512) {
        const int row = idx >> 7, c8 = idx & 127, h = c8 >> 3;
        const float l0 = LSE[((size_t)0 * MT + row) * 16 + h], l1 = LSE[((size_t)1 * MT + row) * 16 + h], l2 = LSE[((size_t)2 * MT + row) * 16 + h];
        const float mx = fmaxf(l0, fmaxf(l1, l2)); const float e0 = __expf(l0 - mx), e1 = __expf(l1 - mx), e2 = __expf(l2 - mx); const float inv = 1.f / (e0 + e1 + e2);
        const float wgt[3] = {e0 * inv, e1 * inv, e2 * inv};
        float acc[8] = {0.f, 0.f, 0.f, 0.f, 0.f, 0.f, 0.f, 0.f};
#pragma unroll
        for (int gi = 0; gi < 3; ++gi) { const v4u x = *(const GAS v4u*)((const bf16*)(F.ws + WS_OG + (size_t)gi * QKV_STRIDE) + (size_t)row * DM + c8 * 8);
            acc[0] += wgt[gi] * bflo(x.x); acc[1] += wgt[gi] * bfhi(x.x); acc[2] += wgt[gi] * bflo(x.y); acc[3] += wgt[gi] * bfhi(x.y);
            acc[4] += wgt[gi] * bflo(x.z); acc[5] += wgt[gi] * bfhi(x.z); acc[6] += wgt[gi] * bflo(x.w); acc[7] += wgt[gi] * bfhi(x.w); }
        *(GAS v4u*)(OM + (size_t)row * DM + c8 * 8) = (v4u){pk2(acc[0], acc[1]), pk2(acc[2], acc[3]), pk2(acc[4], acc[5]), pk2(acc[6], acc[7])};
    }
}

#ifndef STAGGER_TICKS
#define STAGGER_TICKS 0
#endif
__device__ __forceinline__ void stagger_delay(Frame& F, int ticks_total) {
    if (ticks_total > 0) { const unsigned long long t0 = __builtin_amdgcn_s_memrealtime(); const unsigned long long w = (unsigned long long)(((F.bid >> 3) & 15) * ticks_total) >> 4;
        while (__builtin_amdgcn_s_memrealtime() - t0 < w) __builtin_amdgcn_s_sleep(4); }
}
template <class RowEpi>
__device__ __forceinline__ void run_gemm(Frame& F, const bf16* A, const bf16* Bt, int N, int K, const RowEpi& R) {
    stagger_delay(F, STAGGER_TICKS * (N >= 4096 ? 1 : 0));
    pg8::Gemm gm{A, Bt, MP, N, K}; pg8::StaticOrder S; S.init(MP, N, F.G, F.bid);
    EpiWrap<RowEpi> E{R};
    pg8::gemm_phase<EpiWrap<RowEpi>, pg8::StaticOrder>(F.lds, gm, S, E);
    small_gemm<RowEpi>(F, A + (size_t)MP * K, Bt, N, K, R);
}

__global__ void __launch_bounds__(512, 2) mega_fwd(Args args) {
    extern __shared__ __attribute__((aligned(16))) unsigned char lds_raw[];
    Frame F;
    F.lds = (LAS unsigned char*)lds_raw;
    F.tid = threadIdx.x; F.lane = F.tid & 63; F.wave = __builtin_amdgcn_readfirstlane(F.tid >> 6);
    F.G = gridDim.x; F.bid = blockIdx.x;
    F.in = args.in; F.out = args.out; F.ws = args.ws; F.ctlf = (float*)(args.ws + WS_CTL);
    unsigned* ctl = (unsigned*)(args.ws + WS_CTL);
    for (int u = F.tid; u < (LDS_BYTES - LDSCTL_OFF) / 4; u += 512) ((LAS unsigned*)(F.lds + LDSCTL_OFF))[u] = 0u;
    __syncthreads();
    XcdBarrier bar; bar.bar = ctl + CW_BAR; bar.x = 0; bar.st = nullptr;
    if (!MK_PER_PHASE) bar = xcd_barrier_post(ctl + CW_BAR, (volatile LAS unsigned*)(F.lds + MISC_OFF) + 8);
    const int lo = args.ph_lo, hi = args.ph_hi;
#define IN(k) (lo <= (k) && (k) < hi)
#define REPS(k) (1 + (int)((PROBE_DUP >> (k)) & 1u))
#define SEAM(k) do { if (IN(k) && IN((k) + 1)) { xcd_barrier(bar); if (PROBE_DUP & (1u << 23)) xcd_barrier(bar); } } while (0)
    float* rs = F.ctlf + CW_RS;
    if (IN(0)) for (int rep = 0; rep < REPS(0); ++rep) { p0_prologue(F); } SEAM(0);
    if (IN(1)) { RowE1 R{rs, F.ctlf + CW_LB, WSP(bf16, WS_QH), WSP(float, WS_LOGF), WSP(bf16, WS_VH), WSP(bf16, WS_GH)}; run_gemm(F, WSP(bf16, WS_XN), WSP(bf16, WS_W1), 4096, 1024, R); } SEAM(1);
    if (IN(2)) { for (int rep = 0; rep < REPS(14); ++rep) hgrn_b1(F); hgrn_sample(F, rs + MT); if (PROBE_DUP & (1u << 21)) hgrn_sample(F, F.ctlf + 220000); } SEAM(2);
    if (IN(3)) for (int rep = 0; rep < REPS(3); ++rep) { hgrn_scan(F); } SEAM(3);
    if (IN(4)) { hgrn_b3(F, rs + MT); if (PROBE_DUP & (1u << 22)) hgrn_b3(F, F.ctlf + 220000); } SEAM(4);
    if (IN(5)) { RowERes R{rs + MT, F.in[0], F.in[1], nullptr, WSP(bf16, WS_XN), true, rs + 2 * MT}; run_gemm(F, WSP(bf16, WS_A3), WSP(bf16, WS_WOH), 1024, 1024, R);
        if (PROBE_DUP & (1u << 17)) { RowEUp R2{rs + MT, WSP(bf16, WS_OG)}; run_gemm(F, WSP(bf16, WS_A3), WSP(bf16, WS_WOH), 1024, 1024, R2); } } SEAM(5);
    if (IN(6)) { RowEUp R{rs + 2 * MT, WSP(bf16, WS_H)}; run_gemm(F, WSP(bf16, WS_XN), WSP(bf16, WS_WUP0), 4096, 1024, R);
        if (PROBE_DUP & (1u << 6)) run_gemm(F, WSP(bf16, WS_XN), WSP(bf16, WS_WUP0), 4096, 1024, R);
        if (PROBE_DUP & (1u << 25)) { xcd_barrier(bar); run_gemm(F, WSP(bf16, WS_XN), WSP(bf16, WS_WUP0), 4096, 1024, R); }
        if (PROBE_DUP & (1u << 26)) { RowEUp R2{rs + 2 * MT, WSP(bf16, WS_OG)}; run_gemm(F, WSP(bf16, WS_XN), WSP(bf16, WS_WUP0), 4096, 1024, R2); }
        if (PROBE_DUP & (1u << 19)) small_gemm<RowEUp>(F, WSP(bf16, WS_XN) + (size_t)MP * 1024, WSP(bf16, WS_WUP0), 4096, 1024, R); } SEAM(6);
    if (IN(7)) { if (PROBE_DUP & (1u << 18)) { RowEUp R2{rs + MT, WSP(bf16, WS_OG)}; run_gemm(F, WSP(bf16, WS_H), WSP(bf16, WS_WDN0), 1024, 4096, R2); }
        RowERes R{nullptr, nullptr, nullptr, nullptr, WSP(bf16, WS_XN), true, rs + 3 * MT}; run_gemm(F, WSP(bf16, WS_H), WSP(bf16, WS_WDN0), 1024, 4096, R); } SEAM(7);
    if (IN(8)) { RowEQkv R{rs + 3 * MT, F.in[15], F.in[16], F.ws + WS_QKV, F.out}; run_gemm(F, WSP(bf16, WS_XN), WSP(bf16, WS_WQKV), NQKV, 1024, R);
        if (PROBE_DUP & (1u << 8)) run_gemm(F, WSP(bf16, WS_XN), WSP(bf16, WS_WQKV), NQKV, 1024, R);
        if (PROBE_DUP & (1u << 20)) small_gemm<RowEQkv>(F, WSP(bf16, WS_XN) + (size_t)MP * 1024, WSP(bf16, WS_WQKV), NQKV, 1024, R); } SEAM(8);
    if (IN(9)) { const int par = (F.bid >> 3) & 1;
        for (int k = 0; k < 2; ++k) { if ((k ^ par) == 0) { for (int rep = 0; rep < REPS(15); ++rep) attn_sample(F); } else { for (int rep = 0; rep < REPS(16); ++rep) attn_prompt(F); } } } SEAM(9);
    if (IN(10)) for (int rep = 0; rep < REPS(10); ++rep) { attn_merge(F); } SEAM(10);
    if (IN(11)) { RowERes R{nullptr, nullptr, nullptr, nullptr, WSP(bf16, WS_XN), true, rs + 4 * MT}; run_gemm(F, WSP(bf16, WS_OM), WSP(bf16, WS_WOA), 1024, 1024, R); } SEAM(11);
    if (IN(12)) { RowEUp R{rs + 4 * MT, WSP(bf16, WS_H)}; run_gemm(F, WSP(bf16, WS_XN), WSP(bf16, WS_WUP1), 4096, 1024, R); } SEAM(12);
    if (IN(13)) { RowERes R{nullptr, nullptr, nullptr, F.out + O_Y, WSP(bf16, WS_XN), false, nullptr}; run_gemm(F, WSP(bf16, WS_H), WSP(bf16, WS_WDN1), 1024, 4096, R); }
#undef IN
#undef SEAM
#undef REPS
}

extern "C" void kernel_launch(void* const* d_in, const int* in_sizes, int n_in, void* d_out, int out_size, void* d_ws, size_t ws_size, hipStream_t stream) {
    static int grid = 0;
    if (grid == 0) {
        if (n_in != 21 || in_sizes[0] != MP * DM || (size_t)out_size != O_END || ws_size < WS_END) {
            fprintf(stderr, "kernel_launch: unexpected shapes: n_in %d in0 %d out %d ws %zu (need %zu); nothing launched\n", n_in, n_in > 0 ? in_sizes[0] : -1, out_size, ws_size, (size_t)WS_END); grid = -1; return; }
        int dev = 0, cus = 0, per_cu = 0;
        if (hipGetDevice(&dev) != hipSuccess || hipDeviceGetAttribute(&cus, hipDeviceAttributeMultiprocessorCount, dev) != hipSuccess) { fprintf(stderr, "kernel_launch: device query failed\n"); grid = -1; return; }
        if (hipFuncSetAttribute((const void*)mega_fwd, hipFuncAttributeMaxDynamicSharedMemorySize, LDS_BYTES) != hipSuccess) { fprintf(stderr, "kernel_launch: hipFuncSetAttribute failed\n"); grid = -1; return; }
        if (hipOccupancyMaxActiveBlocksPerMultiprocessor(&per_cu, (const void*)mega_fwd, 512, LDS_BYTES) != hipSuccess || per_cu < 1) { fprintf(stderr, "kernel_launch: occupancy query says %d blocks per CU\n", per_cu); (void)hipGetLastError(); grid = -1; return; }
        grid = cus;
    }
    if (grid < 0) return;
    (void)hipMemsetAsync((char*)d_ws + WS_CTL, 0, CTL_ZERO_BYTES, stream);
    Args a{};
    for (int i = 0; i < 21; ++i) a.in[i] = (const float*)d_in[i];
    a.out = (float*)d_out; a.ws = (unsigned char*)d_ws;
#if MK_PER_PHASE
    for (int p = 0; p < NPHASE; ++p) { a.ph_lo = p; a.ph_hi = p + 1; hipLaunchKernelGGL(mega_fwd, dim3(grid), dim3(512), LDS_BYTES, stream, a); }
#else
    a.ph_lo = 0; a.ph_hi = NPHASE;
    hipLaunchKernelGGL(mega_fwd, dim3(grid), dim3(512), LDS_BYTES, stream, a);
    if (PROBE_DUP & (1u << 24)) { (void)hipMemsetAsync((char*)d_ws + WS_CTL, 0, CTL_ZERO_BYTES, stream); hipLaunchKernelGGL(mega_fwd, dim3(grid), dim3(512), LDS_BYTES, stream, a); }
#endif
}
```
